# Optimizing an MI355X kernel written in HIP

```python
import math
import jax, jax.numpy as jnp
from jax import lax
import numpy as np

D_MODEL = 2048
BATCH = 4
SEQ = 8192
DEPTH = 4
DEC_BATCH = 32
DEC_SEQ = 64
PAST_LEN = 4096

CHUNK = 64
N_META = 16
N_MIXERS = 2
N_CONV_LAYERS = (DEPTH + 1) // 2
N_SSD_LAYERS = DEPTH // 2
SC_WIDTH = 3
SSD_INNER = 2 * D_MODEL
SSD_HEADDIM = 64
SSD_HEADS = SSD_INNER // SSD_HEADDIM
SSD_GROUPS = 8
SSD_STATE = 128
SSD_CONV_WIDTH = 4
SSD_CONV_DIM = SSD_INNER + 2 * SSD_GROUPS * SSD_STATE
SSD_BLOCK = 64
D_FF = 5632
FFN_CONV_WIDTH = 3
EPS = 1e-6

kernel_name = 'hybrid_shortconv_ssd_convffn_stream_step'


def rms_norm(x, w):
    xf = x.astype(jnp.float32)
    y = xf * lax.rsqrt(jnp.mean(xf * xf, axis=-1, keepdims=True) + EPS)
    return (y * w.astype(jnp.float32)).astype(x.dtype)


def causal_dwconv(u, buf, w):
    width = w.shape[0]
    L = u.shape[1]
    full = jnp.concatenate([buf.astype(u.dtype), u], axis=1)
    y = sum(w[k] * full[:, k:k + L] for k in range(width))
    return y, full[:, L:]


def pad_seq(t, pad):
    return jnp.pad(t, [(0, 0), (0, pad)] + [(0, 0)] * (t.ndim - 2))


def short_conv_mixer(h, buf, w_in, conv_w, w_out):
    b_gate, c_gate, v = jnp.split(h @ w_in, 3, axis=-1)
    y, new_buf = causal_dwconv(c_gate * v, buf, conv_w)
    return (b_gate * y) @ w_out, new_buf


def ssd_scan(x, dt, A, Bm, Cm, state0):
    b, L = x.shape[:2]
    nc = L // SSD_BLOCK
    hpg = SSD_HEADS // SSD_GROUPS

    def blocks(t):
        return jnp.moveaxis(t.reshape((b, nc, SSD_BLOCK) + t.shape[2:]), 1, 0)

    xs = blocks(x.reshape(b, L, SSD_GROUPS, hpg, SSD_HEADDIM))
    dts = blocks(dt.reshape(b, L, SSD_GROUPS, hpg))
    Bs = blocks(Bm)
    Cs = blocks(Cm)
    Ag = A.reshape(SSD_GROUPS, hpg)
    mask = jnp.tril(jnp.ones((SSD_BLOCK, SSD_BLOCK), dtype=bool))[None, :, :, None, None]

    def step(state, blk):
        xb, dtb, Bb, Cb = blk
        cs = jnp.cumsum(dtb * Ag, axis=1)
        seg = cs[:, :, None] - cs[:, None, :]
        decay = jnp.exp(jnp.where(mask, seg, -jnp.inf))
        w_ij = decay * dtb[:, None]
        cb = jnp.einsum('bign,bjgn->bijg', Cb, Bb)
        y_intra = jnp.einsum('bijg,bijgh,bjghp->bighp', cb, w_ij, xb)
        y_inter = jnp.einsum('bign,bghpn->bighp', Cb, state) * jnp.exp(cs)[..., None]
        last = cs[:, -1]
        w_tail = jnp.exp(last[:, None] - cs) * dtb
        new_state = state * jnp.exp(last)[..., None, None] + jnp.einsum(
            'bjgn,bjgh,bjghp->bghpn', Bb, w_tail, xb)
        return new_state, y_intra + y_inter

    state_g = state0.astype(jnp.float32).reshape(b, SSD_GROUPS, hpg, SSD_HEADDIM, SSD_STATE)
    final, ys = lax.scan(step, state_g, (xs, dts, Bs, Cs))
    y = jnp.moveaxis(ys, 0, 1).reshape(b, L, SSD_HEADS, SSD_HEADDIM)
    return y, final.reshape(b, SSD_HEADS, SSD_HEADDIM, SSD_STATE)


def ssd_mixer(h, conv_buf, ssm_state, w_in, conv_w, conv_b, dt_bias, a_log, d_skip, norm_w, w_out):
    b, L = h.shape[:2]
    f32 = jnp.float32
    z, xbc, dt = jnp.split(h @ w_in, [SSD_INNER, SSD_INNER + SSD_CONV_DIM], axis=-1)
    xbc, new_conv = causal_dwconv(xbc, conv_buf, conv_w)
    xbc = jax.nn.silu(xbc + conv_b)
    xs, Bm, Cm = jnp.split(xbc, [SSD_INNER, SSD_INNER + SSD_GROUPS * SSD_STATE], axis=-1)
    xs = xs.astype(f32).reshape(b, L, SSD_HEADS, SSD_HEADDIM)
    Bm = Bm.astype(f32).reshape(b, L, SSD_GROUPS, SSD_STATE)
    Cm = Cm.astype(f32).reshape(b, L, SSD_GROUPS, SSD_STATE)
    dt = jax.nn.softplus(dt.astype(f32) + dt_bias.astype(f32))
    A = -jnp.exp(a_log.astype(f32))
    pad = (-L) % SSD_BLOCK
    y, new_state = ssd_scan(pad_seq(xs, pad), pad_seq(dt, pad), A,
                            pad_seq(Bm, pad), pad_seq(Cm, pad), ssm_state)
    y = y[:, :L] + d_skip.astype(f32)[:, None] * xs
    g = y.reshape(b, L, SSD_INNER) * jax.nn.silu(z.astype(f32))
    g = g.reshape(b, L, SSD_GROUPS, SSD_INNER // SSD_GROUPS)
    g = g * lax.rsqrt(jnp.mean(g * g, axis=-1, keepdims=True) + EPS)
    g = (g.reshape(b, L, SSD_INNER) * norm_w.astype(f32)).astype(h.dtype)
    return g @ w_out, new_conv, new_state


def conv_ffn(h, buf, w_up, conv_w, conv_b, w_down):
    u, new_buf = causal_dwconv(h @ w_up, buf, conv_w)
    a, v = jnp.split(u + conv_b, 2, axis=-1)
    return (jax.nn.silu(a) * v) @ w_down, new_buf


def trunk(x, conv_a_buf, ssd_conv_buf, ssd_state, ffn_buf,
          norm_mix, norm_ffn, norm_final, sc_w_in, sc_conv_w, sc_w_out,
          ssd_w_in, ssd_conv_w, ssd_conv_b, ssd_dt_bias, ssd_a_log, ssd_d, ssd_norm_w, ssd_w_out,
          ffn_w_up, ffn_conv_w, ffn_conv_b, ffn_w_down):
    new_conv_a, new_ssd_conv, new_ssd, new_ffn = [], [], [], []
    for i in range(DEPTH):
        h = rms_norm(x, norm_mix[i])
        j = i // N_MIXERS
        if i % N_MIXERS == 0:
            out, nb = short_conv_mixer(h, conv_a_buf[j], sc_w_in[j], sc_conv_w[j], sc_w_out[j])
            new_conv_a.append(nb)
        else:
            out, nc, ns = ssd_mixer(h, ssd_conv_buf[j], ssd_state[j], ssd_w_in[j], ssd_conv_w[j],
                                    ssd_conv_b[j], ssd_dt_bias[j], ssd_a_log[j], ssd_d[j],
                                    ssd_norm_w[j], ssd_w_out[j])
            new_ssd_conv.append(nc)
            new_ssd.append(ns)
        x = x + out
        h = rms_norm(x, norm_ffn[i])
        out, nf = conv_ffn(h, ffn_buf[i], ffn_w_up[i], ffn_conv_w[i], ffn_conv_b[i], ffn_w_down[i])
        new_ffn.append(nf)
        x = x + out
    x = rms_norm(x, norm_final)
    return (x, jnp.stack(new_conv_a), jnp.stack(new_ssd_conv), jnp.stack(new_ssd), jnp.stack(new_ffn))


def setup_inputs(seed: int = 0) -> dict:
    key = jax.random.key(seed)
    ks = jax.random.split(key, 32)
    f32 = jnp.float32

    def nrm(k, shape, scale):
        return jax.random.normal(k, shape, f32) * scale

    res = (2 * DEPTH) ** -0.5
    dt0 = jnp.exp(jax.random.uniform(ks[20], (N_SSD_LAYERS, SSD_HEADS), f32,
                                     math.log(1e-3), math.log(1e-1)))
    return {
        'x_prompt': nrm(ks[0], (BATCH, SEQ, D_MODEL), 1.0),
        'x_sample': nrm(ks[1], (DEC_BATCH, DEC_SEQ, D_MODEL), 1.0),
        'state_conv_a': nrm(ks[2], (N_CONV_LAYERS, DEC_BATCH, SC_WIDTH - 1, D_MODEL), 1.0),
        'state_ssd_conv': nrm(ks[3], (N_SSD_LAYERS, DEC_BATCH, SSD_CONV_WIDTH - 1, SSD_CONV_DIM), 1.0),
        'state_ssd': nrm(ks[4], (N_SSD_LAYERS, DEC_BATCH, SSD_HEADS, SSD_HEADDIM, SSD_STATE), 0.1),
        'state_ffn_conv': nrm(ks[5], (DEPTH, DEC_BATCH, FFN_CONV_WIDTH - 1, 2 * D_FF), 1.0),
        'meta_tokens': nrm(ks[6], (N_META, D_MODEL), 1.0),
        'norm_mix': 1.0 + nrm(ks[7], (DEPTH, D_MODEL), 0.02),
        'norm_ffn': 1.0 + nrm(ks[8], (DEPTH, D_MODEL), 0.02),
        'norm_final': 1.0 + nrm(ks[9], (D_MODEL,), 0.02),
        'sc_w_in': nrm(ks[10], (N_CONV_LAYERS, D_MODEL, 3 * D_MODEL), D_MODEL ** -0.5),
        'sc_conv_w': nrm(ks[11], (N_CONV_LAYERS, SC_WIDTH, D_MODEL), SC_WIDTH ** -0.5),
        'sc_w_out': nrm(ks[12], (N_CONV_LAYERS, D_MODEL, D_MODEL), res * D_MODEL ** -0.5),
        'ssd_w_in': nrm(ks[13], (N_SSD_LAYERS, D_MODEL, 2 * SSD_INNER + 2 * SSD_GROUPS * SSD_STATE + SSD_HEADS),
                        D_MODEL ** -0.5),
        'ssd_conv_w': nrm(ks[14], (N_SSD_LAYERS, SSD_CONV_WIDTH, SSD_CONV_DIM), SSD_CONV_WIDTH ** -0.5),
        'ssd_conv_b': nrm(ks[15], (N_SSD_LAYERS, SSD_CONV_DIM), 0.02),
        'ssd_dt_bias': dt0 + jnp.log(-jnp.expm1(-dt0)),
        'ssd_a_log': jnp.log(jax.random.uniform(ks[16], (N_SSD_LAYERS, SSD_HEADS), f32, 1.0, 16.0)),
        'ssd_d': 1.0 + nrm(ks[17], (N_SSD_LAYERS, SSD_HEADS), 0.02),
        'ssd_norm_w': 1.0 + nrm(ks[18], (N_SSD_LAYERS, SSD_INNER), 0.02),
        'ssd_w_out': nrm(ks[19], (N_SSD_LAYERS, SSD_INNER, D_MODEL), res * SSD_INNER ** -0.5),
        'ffn_w_up': nrm(ks[21], (DEPTH, D_MODEL, 2 * D_FF), D_MODEL ** -0.5),
        'ffn_conv_w': nrm(ks[22], (DEPTH, FFN_CONV_WIDTH, 2 * D_FF), FFN_CONV_WIDTH ** -0.5),
        'ffn_conv_b': nrm(ks[23], (DEPTH, 2 * D_FF), 0.02),
        'ffn_w_down': nrm(ks[24], (DEPTH, D_FF, D_MODEL), res * D_FF ** -0.5),
    }


def reference(x_prompt, x_sample, state_conv_a, state_ssd_conv, state_ssd, state_ffn_conv,
              meta_tokens, norm_mix, norm_ffn, norm_final, sc_w_in, sc_conv_w, sc_w_out,
              ssd_w_in, ssd_conv_w, ssd_conv_b, ssd_dt_bias, ssd_a_log, ssd_d, ssd_norm_w, ssd_w_out,
              ffn_w_up, ffn_conv_w, ffn_conv_b, ffn_w_down):
    b = x_prompt.shape[0]
    dtype = x_prompt.dtype
    meta = jnp.broadcast_to(meta_tokens.astype(dtype)[None], (b, N_META, D_MODEL))
    xp = jnp.concatenate([meta, x_prompt], axis=1)
    zero_conv_a = jnp.zeros((N_CONV_LAYERS, b, SC_WIDTH - 1, D_MODEL), dtype)
    zero_ssd_conv = jnp.zeros((N_SSD_LAYERS, b, SSD_CONV_WIDTH - 1, SSD_CONV_DIM), dtype)
    zero_ssd = jnp.zeros((N_SSD_LAYERS, b, SSD_HEADS, SSD_HEADDIM, SSD_STATE), jnp.float32)
    zero_ffn = jnp.zeros((DEPTH, b, FFN_CONV_WIDTH - 1, 2 * D_FF), dtype)
    yp, p_conv_a, p_ssd_conv, p_ssd, p_ffn_conv = trunk(
        xp, zero_conv_a, zero_ssd_conv, zero_ssd, zero_ffn,
        norm_mix, norm_ffn, norm_final, sc_w_in, sc_conv_w, sc_w_out,
        ssd_w_in, ssd_conv_w, ssd_conv_b, ssd_dt_bias, ssd_a_log, ssd_d, ssd_norm_w, ssd_w_out,
        ffn_w_up, ffn_conv_w, ffn_conv_b, ffn_w_down)
    y_prompt = yp[:, N_META:]
    y_sample, s_conv_a, s_ssd_conv, s_ssd, s_ffn_conv = trunk(
        x_sample, state_conv_a, state_ssd_conv, state_ssd, state_ffn_conv,
        norm_mix, norm_ffn, norm_final, sc_w_in, sc_conv_w, sc_w_out,
        ssd_w_in, ssd_conv_w, ssd_conv_b, ssd_dt_bias, ssd_a_log, ssd_d, ssd_norm_w, ssd_w_out,
        ffn_w_up, ffn_conv_w, ffn_conv_b, ffn_w_down)
    return (y_prompt, y_sample, p_conv_a, p_ssd_conv, p_ssd, p_ffn_conv,
            s_conv_a, s_ssd_conv, s_ssd, s_ffn_conv)
```

```cpp
#include <hip/hip_runtime.h>
#include <cstdio>
#include <cstdint>
#ifndef PROBE
#define PROBE 0
#endif

constexpr int D = 2048, NB = 4, SEQ = 8192, NMETA = 16, LP = SEQ + NMETA;
constexpr int NS = 32, LS = 64;
constexpr int TP = NB * LP, TS = NS * LS, T = TP + TS;
constexpr int MP = 35072;
constexpr int DFF = 5632, NUP = 2 * DFF;
constexpr int DI = 4096, NH = 64, HD = 64, NG = 8, NST = 128, CONVD = 6144;
constexpr int NIN = 2 * DI + 2 * NG * NST + NH, NINP = 10496;
constexpr float EPS = 1e-6f;
static_assert(MP % 256 == 0 && MP >= T && NINP % 256 == 0 && NINP >= NIN && NIN == 10304 && T == 34880, "shapes");

enum { I_XP = 0, I_XS, I_ST_CONVA, I_ST_SSDCONV, I_ST_SSD, I_ST_FFN, I_META, I_NMIX, I_NFFN, I_NFINAL, I_SC_WIN, I_SC_CW, I_SC_WOUT,
       I_SSD_WIN, I_SSD_CW, I_SSD_CB, I_SSD_DTB, I_SSD_ALOG, I_SSD_D, I_SSD_NW, I_SSD_WOUT, I_FFN_WUP, I_FFN_CW, I_FFN_CB, I_FFN_WDOWN, N_IN };
constexpr size_t O_YP = 0, O_YS = 67108864, O_PCONVA = 71303168, O_PSSDCONV = 71335936, O_PSSD = 71483392, O_PFFN = 75677696,
                 O_SCONVA = 76038144, O_SSSDCONV = 76300288, O_SSSD = 77479936, O_SFFN = 111034368, O_END = 113917952;

#define GAS __attribute__((address_space(1)))
#define LAS __attribute__((address_space(3)))
typedef unsigned short bf16;
typedef unsigned v4u __attribute__((ext_vector_type(4)));
typedef unsigned v2u __attribute__((ext_vector_type(2)));
typedef float f32x4 __attribute__((ext_vector_type(4)));
typedef float f32x2 __attribute__((ext_vector_type(2)));
typedef float f32x16 __attribute__((ext_vector_type(16)));
typedef short bf16x8 __attribute__((ext_vector_type(8)));
typedef __bf16 bf2_t __attribute__((ext_vector_type(2)));

__device__ __forceinline__ unsigned pk2(float lo, float hi) { f32x2 v = {lo, hi}; bf2_t r = __builtin_convertvector(v, bf2_t); return __builtin_bit_cast(unsigned, r); }
__device__ __forceinline__ int opaque_i(int x) { asm volatile("" : "+v"(x)); return x; }
__device__ __forceinline__ int opaque_s(int x) { asm volatile("" : "+s"(x)); return x; }
__device__ __forceinline__ float shfl_from(float v, int srclane) { return __builtin_bit_cast(float, __builtin_amdgcn_ds_bpermute(srclane << 2, __builtin_bit_cast(int, v))); }
__device__ __forceinline__ float opaque_zero() { float z = 0.f; asm volatile("" : "+v"(z)); return z; }
__device__ __forceinline__ float ss_to_rstd(unsigned long long q) { return __builtin_amdgcn_rsqf((float)q * (1.0f / 1048576.0f / D) + EPS); }
__device__ __forceinline__ float bflo(unsigned u) { return __builtin_bit_cast(float, u << 16); }
__device__ __forceinline__ float bfhi(unsigned u) { return __builtin_bit_cast(float, u & 0xffff0000u); }
__device__ __forceinline__ float fast_rcp(float x) { return __builtin_amdgcn_rcpf(x); }
__device__ __forceinline__ float softplus_f(float v) { return (v > 20.f) ? v : __logf(1.0f + __expf(v)); }
__device__ __forceinline__ float silu_f(float x) { return x * fast_rcp(1.0f + __expf(-x)); }

namespace pg8 {
#define PG8_LAS __attribute__((address_space(3)))
typedef unsigned short bf16_t;
typedef short bf16x8 __attribute__((ext_vector_type(8)));
typedef float f32x4 __attribute__((ext_vector_type(4)));
typedef unsigned u32x4 __attribute__((ext_vector_type(4)));
constexpr int BM = 256, BK = 64, HALF = 128, HTB = HALF * BK * 2  , STAGE_BYTES = 8 * HTB, NXCD = 8, WGM = 4;

__host__ __device__ __forceinline__ int lds_byte(int r, int c) { const int st = (r >> 4) * 2 + (c >> 5), rr = r & 15, cc = c & 31, ob = rr * 64 + cc * 2; return st * 1024 + (ob ^ (((ob >> 9) & 1) << 5)); }
__host__ __device__ __forceinline__ void stage_rc(int b, int& R, int& C) { const int st = b / 1024, sb = b % 1024, swz = sb ^ (((sb >> 9) & 1) << 5); R = (st >> 1) * 16 + swz / 64; C = (st & 1) * 32 + (swz % 64) / 2; }
__host__ __device__ __forceinline__ int perm32(int rho) { const int n = rho >> 4, i = rho & 15; return 8 * (i >> 2) + 4 * n + (i & 3); }

struct Unit { int pm, pn; int kt0, ktn, part, nparts, slot; };
struct Gemm { const bf16_t* A; const bf16_t* Bt; int M, N, K; };

struct RowOrder {
    int nM, nN, nwg, G, c, pm0, wgm, lim, rev;
    __device__ void init(int pm0_, int nM_, int nN_, int G_, int c_) { pm0 = pm0_; nM = nM_; nN = nN_; nwg = nM * nN; G = G_; c = c_; wgm = WGM; lim = nwg; rev = 0; }
    __device__ void unit_of(int wgid, Unit& u) const {
        { const int q = nwg / NXCD, r = nwg % NXCD, xcd = wgid % NXCD, off = wgid / NXCD; wgid = (xcd < r ? xcd * (q + 1) : r * (q + 1) + (xcd - r) * q) + off; }
        const int nig = wgm * nN, gid = wgid / nig, fm = gid * wgm, gsz = (nM - fm) < wgm ? (nM - fm) : wgm;
        u.pm = pm0 + fm + ((wgid % nig) % gsz); u.pn = (wgid % nig) / gsz;
        if (rev) u.pm = pm0 + (nM - 1) - (u.pm - pm0);
    }
    __device__ bool next(int i, Unit& u) const {
        const long L = (long)i * G + c; if (L >= lim) return false;
        unit_of((int)L, u); return true;
    }
    __device__ __forceinline__ void a_ready(const Unit&) const {}
    __device__ __forceinline__ void done(const Unit&) const {}
};
struct RowOrderSK {
    RowOrder R; int first, ns, nt;
    __device__ bool next(int i, Unit& u) const {
        const long Lh = (long)i * R.G + R.c; const int xcd = (int)(Lh % NXCD), offh = (int)(Lh / NXCD);
        const int part = offh % ns; const long L = (long)first + (long)NXCD * (offh / ns) + xcd; if (L >= R.nwg) return false;
        R.unit_of((int)L, u); u.part = part; u.nparts = ns; u.slot = (int)L - first;
        const int pairs = nt >> 1; u.kt0 = 2 * ((part * pairs) / ns); u.ktn = 2 * (((part + 1) * pairs) / ns) - u.kt0; return true;
    }
    __device__ __forceinline__ void a_ready(const Unit&) const {}
    __device__ __forceinline__ void done(const Unit&) const {}
};


struct EpiStore {
    static constexpr bool PERM = true, AFTER_DRAIN = false, SPLITK = false, KGROUP = false, HEADPF = false; static constexpr int AMAP = 0;
    static __device__ __forceinline__ int a_row0(int pm) { return BM * pm; }
    bf16_t* O1; int ld1; int n1; bf16_t* O2; int ld2; int n2; float* F3; int ld3; const unsigned long long* ss; int dry; int ncv0;
    __device__ __forceinline__ void operator()(const f32x4 (&acc)[2][2][4][2], const Unit& u, int wr, int wc, int fr, int fq) const {
        if (dry) return;
        const int row0 = u.pm * BM + wr * 64 + fr;
        float rs[2][4];
#pragma unroll
        for (int ai = 0; ai < 2; ++ai)
#pragma unroll
            for (int m = 0; m < 4; ++m) rs[ai][m] = 0.f;
        {
            unsigned long long q[8];
#pragma unroll
            for (int i = 0; i < 8; ++i) q[i] = ss[row0 + (i >> 2) * HALF + (i & 3) * 16];
            asm volatile("" ::: "memory");
#pragma unroll
            for (int i = 0; i < 8; ++i) rs[i >> 2][i & 3] = ss_to_rstd(q[i]);
        }
        if (u.pn >= ncv0) {
            const int ch0 = 128 * (u.pn - ncv0) + wc * 32 + 8 * fq;
#pragma unroll
            for (int ai = 0; ai < 2; ++ai)
#pragma unroll
                for (int m = 0; m < 4; ++m) { const float r2 = rs[ai][m] * rs[ai][m];
                    const f32x4 p0 = acc[ai][0][m][0] * acc[ai][1][m][0] * r2, p1 = acc[ai][0][m][1] * acc[ai][1][m][1] * r2;
                    u32x4 w; w.x = pk2(p0[0], p0[1]); w.y = pk2(p0[2], p0[3]); w.z = pk2(p1[0], p1[1]); w.w = pk2(p1[2], p1[3]);
                    *(u32x4*)(O2 + (size_t)(row0 + ai * HALF + m * 16) * ld2 + ch0) = w; }
        } else if (u.pn < n2) {
            bf16_t* base; int ld, colt;
            if (u.pn < n1) { base = O1; ld = ld1; colt = u.pn * BM; } else { base = O2; ld = ld2; colt = (u.pn - n1) * BM; }
            const int col0 = colt + wc * 32 + 8 * fq;
#pragma unroll
            for (int ai = 0; ai < 2; ++ai)
#pragma unroll
                for (int m = 0; m < 4; ++m) { bf16_t* rowp = base + (size_t)(row0 + ai * HALF + m * 16) * ld + col0;
#pragma unroll
                    for (int bj = 0; bj < 2; ++bj) { const f32x4 v0 = acc[ai][bj][m][0] * rs[ai][m], v1 = acc[ai][bj][m][1] * rs[ai][m];
                        u32x4 w; w.x = pk2(v0[0], v0[1]); w.y = pk2(v0[2], v0[3]); w.z = pk2(v1[0], v1[1]); w.w = pk2(v1[2], v1[3]);
                        *(u32x4*)(rowp + bj * HALF) = w; } }
        } else {
            const int col0 = wc * 32 + 8 * fq;
            if (col0 < ld3) {
#pragma unroll
                for (int ai = 0; ai < 2; ++ai)
#pragma unroll
                    for (int m = 0; m < 4; ++m) { float* rowp = F3 + (size_t)(row0 + ai * HALF + m * 16) * ld3 + col0;
                        *(f32x4*)(rowp) = acc[ai][0][m][0] * rs[ai][m]; *(f32x4*)(rowp + 4) = acc[ai][0][m][1] * rs[ai][m]; }
            }
        }
    }
};
constexpr int SK_MAXPARTS = 3;
constexpr size_t SK_PART_FLOATS = (size_t)BM * BM;
__device__ __forceinline__ bool sk_exchange(f32x4 (&acc)[2][2][4][2], const Unit& u, float* pbuf, unsigned* flags) {
    const int tid = opaque_i((int)threadIdx.x);
    unsigned* flag = flags + (size_t)u.slot * 64;
    if (u.part != 0) {
        float* dst = pbuf + ((size_t)u.slot * (SK_MAXPARTS - 1) + (u.part - 1)) * SK_PART_FLOATS + (size_t)tid * 4;
#pragma unroll
        for (int q = 0; q < 32; ++q) { const f32x4 v = acc[q >> 4][(q >> 3) & 1][(q >> 1) & 3][q & 1]; float* d = dst + (size_t)q * 2048;
            asm volatile("global_store_dwordx4 %0, %1, off sc1" :: "v"(d), "v"(v) : "memory"); }
        asm volatile("s_waitcnt vmcnt(0)" ::: "memory");
        __builtin_amdgcn_s_barrier();
        if (tid == 0) (void)__hip_atomic_fetch_add(flag, 1u, __ATOMIC_RELAXED, __HIP_MEMORY_SCOPE_AGENT);
        return false;
    }
    const int np = u.nparts;
    if (np > 1) {
        if (tid < 64) {
            unsigned sp = 0;
            while ((unsigned)__builtin_amdgcn_readfirstlane(__hip_atomic_load(flag, __ATOMIC_RELAXED, __HIP_MEMORY_SCOPE_AGENT)) != (unsigned)(np - 1)) { __builtin_amdgcn_s_sleep(1); if (++sp > (1u << 22)) break; }
            __builtin_amdgcn_fence(__ATOMIC_ACQUIRE, "agent");
            asm volatile("s_waitcnt vmcnt(0)" ::: "memory");
        }
        __builtin_amdgcn_s_barrier();
        asm volatile("" ::: "memory");
        for (int p = 1; p < np; ++p) {
            const float* src = pbuf + ((size_t)u.slot * (SK_MAXPARTS - 1) + (p - 1)) * SK_PART_FLOATS + (size_t)tid * 4;
#pragma unroll
            for (int ai = 0; ai < 2; ++ai) {
                f32x4 t[16];
#pragma unroll
                for (int i = 0; i < 16; ++i) t[i] = *(const f32x4*)(src + (size_t)(ai * 16 + i) * 2048);
                asm volatile("" ::: "memory");
#pragma unroll
                for (int i = 0; i < 16; ++i) acc[ai][i >> 3][(i >> 1) & 3][i & 1] += t[i];
            }
        }
    }
    return true;
}
constexpr int KG_TAB_OFF = 131072, KG_TAB_BYTES = 8192;
template <bool SK = false, bool KG = false> struct EpiRes {
    static constexpr bool PERM = true, AFTER_DRAIN = false, SPLITK = SK, KGROUP = KG, HEADPF = false; static constexpr int AMAP = 0;
    static __device__ __forceinline__ int a_row0(int pm) { return BM * pm; }
    bf16_t* XB; unsigned long long* ss; int ldc; int dry;
    float* pbuf; unsigned* flags;
    const unsigned long long* ssg; int ssg_ld;
    __device__ __forceinline__ void kg_build(PG8_LAS float* tab, const Unit& u) const {
        const int t = opaque_i((int)threadIdx.x), lr = t >> 1, g0 = 4 * (t & 1);
        const unsigned long long* p = ssg + (size_t)g0 * ssg_ld + (size_t)u.pm * BM + lr;
        unsigned long long q[4];
#pragma unroll
        for (int i = 0; i < 4; ++i) q[i] = p[(size_t)i * ssg_ld];
        asm volatile("" ::: "memory");
        f32x4 sv;
#pragma unroll
        for (int i = 0; i < 4; ++i) sv[i] = __builtin_amdgcn_rsqf((float)q[i] * (1.0f / 1048576.0f / 512.0f) + 1e-6f);
        *(PG8_LAS f32x4*)(tab + lr * 8 + g0) = sv;
    }
    __device__ __forceinline__ void kg_rescale(f32x4 (&acc)[2][2][4][2], const PG8_LAS float* tab, int g, int wr, int fr) const {
#pragma unroll
        for (int ai = 0; ai < 2; ++ai)
#pragma unroll
            for (int m = 0; m < 4; ++m) { const PG8_LAS float* e = tab + (128 * ai + 64 * wr + 16 * m + fr) * 8 + g; const float ra = e[-1] * __builtin_amdgcn_rcpf(e[0]);
#pragma unroll
                for (int bj = 0; bj < 2; ++bj)
#pragma unroll
                    for (int n = 0; n < 2; ++n) acc[ai][bj][m][n] = acc[ai][bj][m][n] * ra; }
    }
    __device__ __forceinline__ void kg_finish(f32x4 (&acc)[2][2][4][2], const PG8_LAS float* tab, int g, int wr, int fr) const {
#pragma unroll
        for (int ai = 0; ai < 2; ++ai)
#pragma unroll
            for (int m = 0; m < 4; ++m) { const float ra = tab[(128 * ai + 64 * wr + 16 * m + fr) * 8 + g];
#pragma unroll
                for (int bj = 0; bj < 2; ++bj)
#pragma unroll
                    for (int n = 0; n < 2; ++n) acc[ai][bj][m][n] = acc[ai][bj][m][n] * ra; }
    }
    __device__ __forceinline__ bool part_exchange(f32x4 (&acc)[2][2][4][2], const Unit& u) const { return sk_exchange(acc, u, pbuf, flags); }
    __device__ __forceinline__ void operator()(const f32x4 (&acc)[2][2][4][2], const Unit& u, int wr, int wc, int fr, int fq) const {
        if (dry == 1) return;
        const float sc = dry ? 0.5f : 1.0f;
        const int row0 = u.pm * BM + wr * 64 + fr, col0 = u.pn * BM + wc * 32 + 8 * fq;
        u32x4 xin[2][4][2];
#pragma unroll
        for (int ai = 0; ai < 2; ++ai)
#pragma unroll
            for (int m = 0; m < 4; ++m)
#pragma unroll
                for (int bj = 0; bj < 2; ++bj) xin[ai][m][bj] = *(const u32x4*)(XB + (size_t)(row0 + ai * HALF + m * 16) * ldc + col0 + bj * HALF);
        float ssq[8];
#pragma unroll
        for (int ai = 0; ai < 2; ++ai)
#pragma unroll
            for (int m = 0; m < 4; ++m) { const int row = row0 + ai * HALF + m * 16; bf16_t* rowb = XB + (size_t)row * ldc + col0;
                float s = 0.f;
#pragma unroll
                for (int bj = 0; bj < 2; ++bj) {
                    const u32x4 q = xin[ai][m][bj]; const f32x4 a0 = acc[ai][bj][m][0] * sc, a1 = acc[ai][bj][m][1] * sc;
                    u32x4 w; w.x = pk2(bflo(q.x) + a0[0], bfhi(q.x) + a0[1]); w.y = pk2(bflo(q.y) + a0[2], bfhi(q.y) + a0[3]); w.z = pk2(bflo(q.z) + a1[0], bfhi(q.z) + a1[1]); w.w = pk2(bflo(q.w) + a1[2], bfhi(q.w) + a1[3]);
                    *(u32x4*)(rowb + bj * HALF) = w;
                    const float r0 = bflo(w.x), r1 = bfhi(w.x), r2 = bflo(w.y), r3 = bfhi(w.y), r4 = bflo(w.z), r5 = bfhi(w.z), r6 = bflo(w.w), r7 = bfhi(w.w);
                    s += ((r0 * r0 + r1 * r1) + (r2 * r2 + r3 * r3)) + ((r4 * r4 + r5 * r5) + (r6 * r6 + r7 * r7));
                }
                ssq[ai * 4 + m] = s;
            }
        {
            const int ln = opaque_i((int)threadIdx.x) & 63;
            float t[8];
#pragma unroll
            for (int i = 0; i < 8; ++i) t[i] = shfl_from(ssq[i], ln ^ 16);
#pragma unroll
            for (int i = 0; i < 8; ++i) ssq[i] += t[i];
#pragma unroll
            for (int i = 0; i < 8; ++i) t[i] = shfl_from(ssq[i], ln ^ 32);
#pragma unroll
            for (int i = 0; i < 8; ++i) ssq[i] += t[i];
        }
        if (fq == 0 && dry != 2) {
#pragma unroll
            for (int i = 0; i < 8; ++i) atomicAdd(ss + row0 + (i >> 2) * HALF + (i & 3) * 16, (unsigned long long)(ssq[i] * 1048576.0f + 0.5f));
        }
    }
};


__device__ __forceinline__ f32x2 silu2(f32x2 x) {
    f32x2 t = x * (-1.44269504f); t.x = __builtin_amdgcn_exp2f(t.x); t.y = __builtin_amdgcn_exp2f(t.y); t = t + 1.0f;
    f32x2 r; r.x = __builtin_amdgcn_rcpf(t.x); r.y = __builtin_amdgcn_rcpf(t.y); return x * r; }
__device__ __forceinline__ float dpp_shr1(float x) { return __builtin_bit_cast(float, __builtin_amdgcn_update_dpp(0, __builtin_bit_cast(int, x), 0x111, 0xf, 0xf, true)); }
__device__ __forceinline__ f32x2 dpp_shr1_2(f32x2 x) { f32x2 r; r.x = dpp_shr1(x.x); r.y = dpp_shr1(x.y); return r; }
struct EpiFfn {
    static constexpr bool PERM = true, AFTER_DRAIN = false, SPLITK = false, KGROUP = false, HEADPF = true; static constexpr int AMAP = 2;
    __device__ __forceinline__ void head_dma(const Unit& u, int b) const {
        const int tid2 = opaque_i((int)threadIdx.x), wid2 = __builtin_amdgcn_readfirstlane(tid2 >> 6), wr = wid2 >> 2, wc = wid2 & 3, ln = tid2 & 63;
        const int upm = opaque_s(u.pm), upn = opaque_s(u.pn);
        const int cc = ln & 31, hv = ln >> 5, wcol = (hv ? DFF : 0) + 128 * upn + 32 * wc + cc;
        PG8_LAS unsigned* wlw = (PG8_LAS unsigned*)(wl + b * 12288 + 1536 * (wr * 4 + wc));
        __builtin_amdgcn_global_load_lds((const unsigned*)(cw + wcol), wlw, 4, 0, 0);
        __builtin_amdgcn_global_load_lds((const unsigned*)(cw + NUP + wcol), wlw + 64, 4, 0, 0);
        __builtin_amdgcn_global_load_lds((const unsigned*)(cw + 2 * NUP + wcol), wlw + 128, 4, 0, 0);
        __builtin_amdgcn_global_load_lds((const unsigned*)(cb + wcol), wlw + 192, 4, 0, 0);
        if (wc == 0) {
            const unsigned* sp = (const unsigned*)(ss + (252 * upm - 2 + 126 * wr)) + ln;
            PG8_LAS unsigned* sl = (PG8_LAS unsigned*)(wl + 24576 + b * 2048 + wr * 1024);
#pragma unroll
            for (int k = 0; k < 4; ++k) __builtin_amdgcn_global_load_lds(sp + 64 * k, sl + 64 * k, 4, 0, 0);
        }
    }
    static __device__ __forceinline__ int a_row0(int pm) { return 252 * pm - 2; }
    bf16_t* ACT; const float* cw; const float* cb; const float* st; float* outp; float* outs; const unsigned long long* ss; int dry; PG8_LAS unsigned char* wl;
    __device__ __forceinline__ void operator()(const f32x4 (&acc)[2][2][4][2], const Unit& u, int wr_, int wc_, int fr_, int fq_, int hb) const {
        if (dry) return;
        const int tid2 = opaque_i((int)threadIdx.x), wid2 = __builtin_amdgcn_readfirstlane(tid2 >> 6);
        const int upm = opaque_s(u.pm), upn = opaque_s(u.pn), wr = wid2 >> 2, wc = wid2 & 3, fr = tid2 & 15, fq = (tid2 >> 4) & 3; (void)wr_; (void)wc_; (void)fr_; (void)fq_;
        const int span0 = 252 * upm - 2 + 126 * wr, rowb = span0 + 8 * fr;
        const int colj = 128 * upn + 32 * wc + 8 * fq;
        bool slow; { const int b = span0 + 128, k = (span0 + (LP - 2)) / LP; slow = (b > TP - 2) || (LP * k - 2 < b); }
        const int ln = tid2 & 63;
        PG8_LAS float* wlw = (PG8_LAS float*)(wl + hb * 12288 + 1536 * (wr * 4 + wc));
        float rs[8];
        {
            const PG8_LAS unsigned long long* sq = (const PG8_LAS unsigned long long*)(wl + 24576 + hb * 2048 + wr * 1024) + 8 * fr;
#pragma unroll
            for (int i = 0; i < 8; ++i) rs[i] = ss_to_rstd(sq[i]);
            (void)ln; (void)rowb;
        }
        unsigned pkd[8][4];
#pragma unroll
        for (int cq = 0; cq < 2; ++cq) {
#pragma unroll
            for (int cp2 = 0; cp2 < 2; ++cp2) {
                const int cp = 2 * cq + cp2, ca0 = colj + 2 * cp, cv0 = DFF + colj + 2 * cp;
                const PG8_LAS float* wq = wlw + 8 * fq + 2 * cp;
                const f32x2 w0a = *(const PG8_LAS f32x2*)(wq), w1a = *(const PG8_LAS f32x2*)(wq + 64), w2a = *(const PG8_LAS f32x2*)(wq + 128), ba = *(const PG8_LAS f32x2*)(wq + 192);
                const f32x2 w0v = *(const PG8_LAS f32x2*)(wq + 32), w1v = *(const PG8_LAS f32x2*)(wq + 96), w2v = *(const PG8_LAS f32x2*)(wq + 160), bv = *(const PG8_LAS f32x2*)(wq + 224);
                f32x2 a[10], v[10];
#pragma unroll
                for (int i = 0; i < 8; ++i) { const f32x4 A4 = acc[i >> 2][0][i & 3][cq], V4 = acc[i >> 2][1][i & 3][cq];
                    a[i + 2] = (cp2 ? (f32x2){A4[2], A4[3]} : (f32x2){A4[0], A4[1]}) * rs[i]; v[i + 2] = (cp2 ? (f32x2){V4[2], V4[3]} : (f32x2){V4[0], V4[1]}) * rs[i]; }
                a[1] = dpp_shr1_2(a[9]); a[0] = dpp_shr1_2(a[8]); v[1] = dpp_shr1_2(v[9]); v[0] = dpp_shr1_2(v[8]);
                if (!slow) {
#pragma unroll
                    for (int i = 0; i < 8; ++i) {
                        const f32x2 sa = w0a * a[i] + (w1a * a[i + 1] + (w2a * a[i + 2] + ba)), sv = w0v * v[i] + (w1v * v[i + 1] + (w2v * v[i + 2] + bv));
                        const f32x2 o = silu2(sa) * sv; pkd[i][2 * cq + cp2] = pk2(o.x, o.y);
                    }
                } else {
#pragma unroll
                    for (int i = 0; i < 8; ++i) {
                        f32x2 p2a = a[i], p1a = a[i + 1], p2v = v[i], p1v = v[i + 1];
                        const int r = rowb + i;
                        if (r >= 0 && r < T) {
                            int seq, pos, L; bool sample;
                            if (r < TP) { sample = false; seq = r / LP; pos = r - seq * LP; L = LP; } else { const int q = r - TP; sample = true; seq = q >> 6; pos = q & 63; L = LS; }
                            if (pos < 2) {
                                f32x2 h1a = {0.f, 0.f}, h2a = {0.f, 0.f}, h1v = {0.f, 0.f}, h2v = {0.f, 0.f};
                                if (sample) { const float* s = st + (size_t)seq * 2 * NUP; h2a = *(const f32x2*)(s + ca0); h1a = *(const f32x2*)(s + NUP + ca0); h2v = *(const f32x2*)(s + cv0); h1v = *(const f32x2*)(s + NUP + cv0); }
                                if (pos == 0) { p1a = h1a; p2a = h2a; p1v = h1v; p2v = h2v; } else { p2a = h1a; p2v = h1v; }
                            }
                            if (pos >= L - 2 && !(fr == 0 && i < 2)) {
                                float* ob = (sample ? outs : outp) + ((size_t)seq * 2 + (pos - (L - 2))) * NUP;
                                *(f32x2*)(ob + ca0) = a[i + 2]; *(f32x2*)(ob + cv0) = v[i + 2];
                            }
                        }
                        const f32x2 sa = w0a * p2a + (w1a * p1a + (w2a * a[i + 2] + ba)), sv = w0v * p2v + (w1v * p1v + (w2v * v[i + 2] + bv));
                        const f32x2 o = silu2(sa) * sv; pkd[i][2 * cq + cp2] = pk2(o.x, o.y);
                    }
                }
            }
        }
#pragma unroll
        for (int i = 0; i < 8; ++i) {
            if (!(fr == 0 && i < 2)) { u32x4 w; w.x = pkd[i][0]; w.y = pkd[i][1]; w.z = pkd[i][2]; w.w = pkd[i][3]; *(u32x4*)((char*)ACT + (unsigned)((rowb + i) * DFF + colj) * 2u) = w; }
        }
    }
};

template <bool SK = false> struct EpiSsdIn {
    static constexpr bool PERM = true, AFTER_DRAIN = false, SPLITK = SK, KGROUP = false, HEADPF = true; static constexpr int AMAP = 3;
    __device__ __forceinline__ void head_dma(const Unit& u, int b) const {
        const int tid2 = opaque_i((int)threadIdx.x), wid2 = __builtin_amdgcn_readfirstlane(tid2 >> 6), wr = wid2 >> 2, wc = wid2 & 3, ln = tid2 & 63;
        const int upm = opaque_s(u.pm), upn = opaque_s(u.pn);
        if (upn >= 16 && upn < 40) {
            const int cc = ln & 31, hv = ln >> 5, wcol = 256 * (upn - 16) + 128 * hv + 32 * wc + cc;
            PG8_LAS unsigned* wlw = (PG8_LAS unsigned*)(wl + b * 12288 + 1536 * (wr * 4 + wc));
#pragma unroll
            for (int k = 0; k < 4; ++k) __builtin_amdgcn_global_load_lds((const unsigned*)(cw + k * CONVD + wcol), wlw + 64 * k, 4, 0, 0);
            __builtin_amdgcn_global_load_lds((const unsigned*)(cb + wcol), wlw + 256, 4, 0, 0);
        }
        if (wc == 0) {
            const unsigned* sp = (const unsigned*)(ss + (250 * upm - 3 + 125 * wr)) + ln;
            PG8_LAS unsigned* sl = (PG8_LAS unsigned*)(wl + 24576 + b * 2048 + wr * 1024);
#pragma unroll
            for (int k = 0; k < 4; ++k) __builtin_amdgcn_global_load_lds(sp + 64 * k, sl + 64 * k, 4, 0, 0);
        }
    }
    static __device__ __forceinline__ int a_row0(int pm) { return 250 * pm - 3; }
    bf16_t* Z; bf16_t* XBC; float* DTo; const unsigned long long* ss; const float* cw; const float* cb; const float* dtb; float* rawb; float* outp; float* outs; int dry; PG8_LAS unsigned char* wl;
    float* pbuf; unsigned* flags;
    __device__ __forceinline__ bool part_exchange(f32x4 (&acc)[2][2][4][2], const Unit& u) const { return sk_exchange(acc, u, pbuf, flags); }
    __device__ __forceinline__ void operator()(const f32x4 (&acc)[2][2][4][2], const Unit& u, int wr_, int wc_, int fr_, int fq_, int hb) const {
        if (dry) return;
        const int tid2 = opaque_i((int)threadIdx.x), wid2 = __builtin_amdgcn_readfirstlane(tid2 >> 6);
        const int upm = opaque_s(u.pm), upn = opaque_s(u.pn), wr = wid2 >> 2, wc = wid2 & 3, fr = tid2 & 15, fq = (tid2 >> 4) & 3; (void)wr_; (void)wc_; (void)fr_; (void)fq_;
        const int span0 = 250 * upm - 3 + 125 * wr, rowb = span0 + 8 * fr;
        float rs[8];
        PG8_LAS float* wlw = (PG8_LAS float*)(wl + hb * 12288 + 1536 * (wr * 4 + wc));
        {
            const PG8_LAS unsigned long long* sq = (const PG8_LAS unsigned long long*)(wl + 24576 + hb * 2048 + wr * 1024) + 8 * fr;
#pragma unroll
            for (int i = 0; i < 8; ++i) rs[i] = ss_to_rstd(sq[i]);
        }
        if (upn < 16) {
            const int col0 = 256 * upn + 32 * wc + 8 * fq;
#pragma unroll
            for (int i = 0; i < 8; ++i) {
                if (!(fr == 0 && i < 3)) {
#pragma unroll
                    for (int bj = 0; bj < 2; ++bj) { const f32x4 v0 = acc[i >> 2][bj][i & 3][0] * rs[i], v1 = acc[i >> 2][bj][i & 3][1] * rs[i];
                        u32x4 w; w.x = pk2(v0[0], v0[1]); w.y = pk2(v0[2], v0[3]); w.z = pk2(v1[0], v1[1]); w.w = pk2(v1[2], v1[3]);
                        *(u32x4*)((char*)Z + (unsigned)((rowb + i) * DI + col0 + bj * HALF) * 2u) = w; }
                }
            }
        } else if (upn < 40) {
            const int colx0 = 256 * (upn - 16) + 32 * wc + 8 * fq;
            bool slow; { const int b = span0 + 128, k = (span0 + (LP - 3)) / LP; slow = (b > TP - 3) || (LP * k - 3 < b); }
            if (slow) {
#pragma unroll
                for (int i = 0; i < 8; ++i) {
                    const int r = rowb + i;
                    if (r >= 0 && r < T && !(fr == 0 && i < 3)) {
                        int seq, pos, L, sid; bool sample;
                        if (r < TP) { sample = false; seq = r / LP; pos = r - seq * LP; L = LP; sid = seq; } else { const int q = r - TP; sample = true; seq = q >> 6; pos = q & 63; L = LS; sid = NB + seq; }
                        float* ob = nullptr;
                        if (pos < 3) ob = rawb + (size_t)(sid * 3 + pos) * CONVD; else if (pos >= L - 3) ob = (sample ? outs : outp) + (size_t)(seq * 3 + (pos - (L - 3))) * CONVD;
                        if (ob) {
#pragma unroll
                            for (int bj = 0; bj < 2; ++bj)
#pragma unroll
                                for (int n = 0; n < 2; ++n) *(f32x4*)(ob + colx0 + 128 * bj + 4 * n) = acc[i >> 2][bj][i & 3][n] * rs[i];
                        }
                    }
                }
            }
#pragma unroll
            for (int bj = 0; bj < 2; ++bj) {
#pragma unroll
                for (int cq = 0; cq < 2; ++cq) {
                    const int colx = colx0 + 128 * bj + 4 * cq;
                    unsigned pkd[8][2];
#pragma unroll
                    for (int cp2 = 0; cp2 < 2; ++cp2) {
                        const PG8_LAS float* wq = wlw + 32 * bj + 8 * fq + 4 * cq + 2 * cp2;
                        const f32x2 w0 = *(const PG8_LAS f32x2*)(wq), w1 = *(const PG8_LAS f32x2*)(wq + 64), w2 = *(const PG8_LAS f32x2*)(wq + 128), w3 = *(const PG8_LAS f32x2*)(wq + 192), bb = *(const PG8_LAS f32x2*)(wq + 256);
                        f32x2 uu[11];
#pragma unroll
                        for (int i = 0; i < 8; ++i) { const f32x4 A4 = acc[i >> 2][bj][i & 3][cq]; uu[i + 3] = (cp2 ? (f32x2){A4[2], A4[3]} : (f32x2){A4[0], A4[1]}) * rs[i]; }
                        uu[2] = dpp_shr1_2(uu[10]); uu[1] = dpp_shr1_2(uu[9]); uu[0] = dpp_shr1_2(uu[8]);
#pragma unroll
                        for (int i = 0; i < 8; ++i) { const f32x2 ov = silu2((w0 * uu[i] + w1 * uu[i + 1]) + (w2 * uu[i + 2] + (w3 * uu[i + 3] + bb))); pkd[i][cp2] = pk2(ov.x, ov.y); }
                    }
#pragma unroll
                    for (int i = 0; i < 8; ++i) {
                        if (!(fr == 0 && i < 3)) { v2u w; w.x = pkd[i][0]; w.y = pkd[i][1]; *(v2u*)((char*)XBC + (unsigned)((rowb + i) * CONVD + colx) * 2u) = w; }
                    }
                }
            }
        } else {
            const int col0 = 32 * wc + 8 * fq;
            if (col0 < NH) {
                const f32x4 b0 = *(const f32x4*)(dtb + col0), b1 = *(const f32x4*)(dtb + col0 + 4);
#pragma unroll
                for (int i = 0; i < 8; ++i) {
                    if (!(fr == 0 && i < 3)) {
                        f32x4 v0 = acc[i >> 2][0][i & 3][0] * rs[i] + b0, v1 = acc[i >> 2][0][i & 3][1] * rs[i] + b1;
#pragma unroll
                        for (int e = 0; e < 4; ++e) { v0[e] = softplus_f(v0[e]); v1[e] = softplus_f(v1[e]); }
                        char* rowp = (char*)DTo + (unsigned)((rowb + i) * NH + col0) * 4u;
                        *(f32x4*)rowp = v0; *(f32x4*)(rowp + 16) = v1;
                    }
                }
            }
        }
    }
};

template <class Epi, class Sched, bool ALIGN_EPI = false, bool SP2 = false>
__device__ __forceinline__ void gemm_phase(PG8_LAS unsigned char* lds, const Gemm g, const Sched& S, const Epi& E) {
    const int tid = opaque_i((int)threadIdx.x), wid = __builtin_amdgcn_readfirstlane(tid >> 6), lane = tid & 63, wr = wid >> 2, wc = wid & 3, fr = lane & 15, fq = lane >> 4;
    const int K = g.K, nt = K / BK;
    constexpr bool SK = Epi::SPLITK;
    constexpr bool KG = Epi::KGROUP;
    unsigned voffA[2], voffB[2];
#pragma unroll
    for (int i = 0; i < 2; ++i) { int R, C; stage_rc(tid * 16 + i * 8192, R, C); const int Rb = Epi::PERM ? ((R & ~31) + perm32(R & 31)) : R;
        const int Ra = Epi::AMAP ? ((128 - Epi::AMAP) * (R >> 6) + 8 * (R & 15) + ((R >> 4) & 3)) : R;
        voffA[i] = (unsigned)(Ra * K + C) * 2u; voffB[i] = (unsigned)(Rb * K + C) * 2u; }
    const size_t kstep = (size_t)(BK * 2);
    const size_t hstepB = (size_t)HALF * K * 2;
    const size_t hstepA = Epi::AMAP ? (size_t)4 * K * 2 : hstepB;
    const size_t tstepB = 2 * hstepB;
    const size_t rstepA = (size_t)K * 2;
    const unsigned ldsw = (unsigned)wid * 1024u;
    const int aoff = lds_byte(wr * 64 + fr, fq * 8), boff = lds_byte(wc * 32 + fr, fq * 8);
#define PG8_SA(b, h) (((b) * 2 + (h)) * HTB)
#define PG8_SB(b, h) ((4 + (b) * 2 + (h)) * HTB)
#define PG8_STAGE(bufoff, gbase, voff) do { _Pragma("unroll") for (int _i = 0; _i < 2; ++_i) \
        __builtin_amdgcn_global_load_lds((const unsigned*)((const char*)(gbase) + (voff)[_i]), (PG8_LAS unsigned*)(lds + (bufoff) + ldsw + _i * 8192), 16, 0, 0); } while (0)
#define PG8_LDA(dst, b, h) do { _Pragma("unroll") for (int m = 0; m < 4; ++m) _Pragma("unroll") for (int k = 0; k < 2; ++k) dst[m][k] = *(const PG8_LAS bf16x8*)(lds + PG8_SA(b, h) + aoff + m * 2048 + k * 1024); } while (0)
#define PG8_LDB(dst, b, h) do { _Pragma("unroll") for (int n = 0; n < 2; ++n) _Pragma("unroll") for (int k = 0; k < 2; ++k) dst[n][k] = *(const PG8_LAS bf16x8*)(lds + PG8_SB(b, h) + boff + n * 2048 + k * 1024); } while (0)
#define PG8_MMA(ai, bj, At, Bt) do { __builtin_amdgcn_s_setprio(1); _Pragma("unroll") for (int m = 0; m < 4; ++m) _Pragma("unroll") for (int n = 0; n < 2; ++n) _Pragma("unroll") for (int k = 0; k < 2; ++k) \
        acc[ai][bj][m][n] = __builtin_amdgcn_mfma_f32_16x16x32_bf16(Bt[n][k], At[m][k], acc[ai][bj][m][n], 0, 0, 0); __builtin_amdgcn_s_setprio(0); } while (0)
#define PG8_WAIT_V(n) asm volatile("s_waitcnt vmcnt(" #n ")" ::: "memory")
#define PG8_WAIT_L(n) asm volatile("s_waitcnt lgkmcnt(" #n ")" ::: "memory")
#define PG8_BAR __builtin_amdgcn_s_barrier()
#define PG8_SCHED __builtin_amdgcn_sched_barrier(0)
    Unit cur, nxt; int ui = 0;
    if (!S.next(0, cur)) return;
    f32x4 acc[2][2][4][2];
    float zacc = opaque_zero();
#pragma unroll
    for (int a = 0; a < 2; ++a)
#pragma unroll
        for (int b = 0; b < 2; ++b)
#pragma unroll
            for (int m = 0; m < 4; ++m)
#pragma unroll
                for (int n = 0; n < 2; ++n) { const float z = zacc; acc[a][b][m][n] = (f32x4){z, z, z, z}; }
    bf16x8 At[4][2], B0[2][2], B1[2][2];
    const char* cA = (const char*)g.A + (ptrdiff_t)Epi::a_row0(cur.pm) * (ptrdiff_t)rstepA; const char* cB = (const char*)g.Bt + (size_t)cur.pn * tstepB;
    if constexpr (Epi::HEADPF) E.head_dma(cur, 0);
    int ntu = nt, kt0u = 0;
    if constexpr (SK) { cA += (size_t)cur.kt0 * kstep; cB += (size_t)cur.kt0 * kstep; ntu = cur.ktn; kt0u = cur.kt0; }
    if constexpr (KG) E.kg_build((PG8_LAS float*)(lds + KG_TAB_OFF), cur);
    S.a_ready(cur);
    if constexpr (SP2) {
        PG8_STAGE(PG8_SB(0, 0), cB, voffB); PG8_STAGE(PG8_SB(0, 1), cB + hstepB, voffB); PG8_STAGE(PG8_SA(0, 0), cA, voffA); PG8_STAGE(PG8_SA(0, 1), cA + hstepA, voffA);
        if (wr == 1) PG8_BAR;
        PG8_WAIT_V(2); PG8_BAR;
        PG8_STAGE(PG8_SB(1, 0), cB + kstep, voffB); PG8_STAGE(PG8_SA(1, 0), cA + kstep, voffA); PG8_STAGE(PG8_SB(1, 1), cB + hstepB + kstep, voffB);
        PG8_WAIT_V(6); PG8_BAR;
    } else {
        PG8_STAGE(PG8_SB(0, 0), cB, voffB); PG8_STAGE(PG8_SA(0, 0), cA, voffA); PG8_STAGE(PG8_SB(0, 1), cB + hstepB, voffB); PG8_STAGE(PG8_SA(0, 1), cA + hstepA, voffA);
        if (wr == 1) PG8_BAR;
        PG8_WAIT_V(4); PG8_BAR;
        PG8_STAGE(PG8_SB(1, 0), cB + kstep, voffB); PG8_STAGE(PG8_SA(1, 0), cA + kstep, voffA); PG8_STAGE(PG8_SB(1, 1), cB + hstepB + kstep, voffB);
        PG8_WAIT_V(6); PG8_BAR;
    }
    for (;;) {
        const bool has_next = S.next(ui + 1, nxt);
        const char* nA = has_next ? (const char*)g.A + (ptrdiff_t)Epi::a_row0(nxt.pm) * (ptrdiff_t)rstepA : cA; const char* nB = has_next ? (const char*)g.Bt + (size_t)nxt.pn * tstepB : cB;
        if constexpr (SK) { if (has_next) { nA += (size_t)nxt.kt0 * kstep; nB += (size_t)nxt.kt0 * kstep; } }
        for (int t = 0; t < ntu; t += 2) {
            const bool last = (t == ntu - 2);
            const char* a1 = cA + (size_t)(t + 1) * kstep;
            const char* a2 = last ? nA : cA + (size_t)(t + 2) * kstep; const char* b2 = last ? nB : cB + (size_t)(t + 2) * kstep;
            const char* a3 = a2 + kstep; const char* b3 = b2 + kstep;
            if (last && has_next) S.a_ready(nxt);
            if constexpr (SP2) {
            PG8_LDB(B0, 0, 0); PG8_LDB(B1, 0, 1); PG8_SCHED; PG8_LDA(At, 0, 0); PG8_STAGE(PG8_SA(1, 1), a1 + hstepA, voffA);
            PG8_WAIT_V(8); PG8_WAIT_L(0); PG8_BAR; PG8_MMA(0, 0, At, B0); PG8_MMA(0, 1, At, B1); PG8_BAR; PG8_SCHED;
            PG8_LDA(At, 0, 1); PG8_STAGE(PG8_SB(0, 0), b2, voffB); PG8_STAGE(PG8_SB(0, 1), b2 + hstepB, voffB); PG8_STAGE(PG8_SA(0, 0), a2, voffA);
            PG8_WAIT_V(8); PG8_WAIT_L(0); PG8_BAR; PG8_MMA(1, 0, At, B0); PG8_MMA(1, 1, At, B1); PG8_BAR; PG8_SCHED;
            PG8_LDB(B0, 1, 0); PG8_LDB(B1, 1, 1); PG8_SCHED; PG8_LDA(At, 1, 0); PG8_STAGE(PG8_SA(0, 1), a2 + hstepA, voffA);
            PG8_WAIT_V(8); PG8_WAIT_L(0); PG8_BAR; PG8_MMA(0, 0, At, B0); PG8_MMA(0, 1, At, B1); PG8_BAR; PG8_SCHED;
            PG8_LDA(At, 1, 1); PG8_STAGE(PG8_SB(1, 0), b3, voffB); PG8_STAGE(PG8_SB(1, 1), b3 + hstepB, voffB); PG8_STAGE(PG8_SA(1, 0), a3, voffA);
            PG8_WAIT_V(8); PG8_WAIT_L(0); PG8_BAR; PG8_MMA(1, 0, At, B0); PG8_MMA(1, 1, At, B1); PG8_BAR; PG8_SCHED;
            } else {
            PG8_LDB(B0, 0, 0); PG8_SCHED; PG8_LDA(At, 0, 0); PG8_STAGE(PG8_SA(1, 1), a1 + hstepA, voffA);
            PG8_WAIT_L(8); PG8_BAR; PG8_WAIT_L(0); PG8_MMA(0, 0, At, B0); PG8_BAR; PG8_SCHED;
            PG8_LDB(B1, 0, 1); PG8_STAGE(PG8_SB(0, 0), b2, voffB);
            PG8_BAR; PG8_WAIT_L(0); PG8_MMA(0, 1, At, B1); PG8_BAR;
            PG8_LDA(At, 0, 1); PG8_STAGE(PG8_SA(0, 0), a2, voffA);
            PG8_BAR; PG8_WAIT_L(0); PG8_MMA(1, 0, At, B0); PG8_BAR; PG8_SCHED;
            PG8_STAGE(PG8_SB(0, 1), b2 + hstepB, voffB);
            PG8_WAIT_V(6); PG8_BAR; PG8_MMA(1, 1, At, B1); PG8_BAR;
            PG8_LDB(B0, 1, 0); PG8_SCHED; PG8_LDA(At, 1, 0); PG8_STAGE(PG8_SA(0, 1), a2 + hstepA, voffA);
            PG8_WAIT_L(8); PG8_BAR; PG8_WAIT_L(0); PG8_MMA(0, 0, At, B0); PG8_BAR; PG8_SCHED;
            PG8_LDB(B1, 1, 1); PG8_STAGE(PG8_SB(1, 0), b3, voffB);
            PG8_BAR; PG8_WAIT_L(0); PG8_MMA(0, 1, At, B1); PG8_BAR;
            PG8_LDA(At, 1, 1); PG8_STAGE(PG8_SA(1, 0), a3, voffA);
            PG8_BAR; PG8_WAIT_L(0); PG8_MMA(1, 0, At, B0); PG8_BAR; PG8_SCHED;
            PG8_STAGE(PG8_SB(1, 1), b3 + hstepB, voffB);
            PG8_WAIT_V(6); PG8_BAR; PG8_MMA(1, 1, At, B1); PG8_BAR;
            }
            if constexpr (KG) { const int ta = kt0u + t + 2; if ((ta & 7) == 0 && t + 2 < ntu) E.kg_rescale(acc, (const PG8_LAS float*)(lds + KG_TAB_OFF + (ui & 1) * KG_TAB_BYTES), ta >> 3, wr, fr); }
        }
        if constexpr (KG) E.kg_finish(acc, (const PG8_LAS float*)(lds + KG_TAB_OFF + (ui & 1) * KG_TAB_BYTES), (kt0u + ntu - 1) >> 3, wr, fr);
        if constexpr (ALIGN_EPI) { if (wr == 0) PG8_BAR; }
        if constexpr (Epi::HEADPF) { if (has_next) E.head_dma(nxt, (ui & 1) ^ 1); }
        if constexpr (SK) { bool ep = E.part_exchange(acc, cur); if (ep) { if constexpr (Epi::HEADPF) E(acc, cur, wr, wc, fr, fq, ui & 1); else E(acc, cur, wr, wc, fr, fq); } if (has_next) { ntu = nxt.ktn; kt0u = nxt.kt0; } }
        else if constexpr (Epi::HEADPF) { E(acc, cur, wr, wc, fr, fq, ui & 1); S.done(cur); }
        else if constexpr (!Epi::AFTER_DRAIN) { E(acc, cur, wr, wc, fr, fq); S.done(cur); }
        if (!has_next) break;
        zacc = opaque_zero();
#pragma unroll
        for (int a = 0; a < 2; ++a)
#pragma unroll
            for (int b = 0; b < 2; ++b)
#pragma unroll
                for (int m = 0; m < 4; ++m)
#pragma unroll
                    for (int n = 0; n < 2; ++n) { const float z = zacc; acc[a][b][m][n] = (f32x4){z, z, z, z}; }
        cur = nxt; cA = nA; cB = nB; ++ui;
        if constexpr (KG) E.kg_build((PG8_LAS float*)(lds + KG_TAB_OFF + (ui & 1) * KG_TAB_BYTES), cur);
        if constexpr (ALIGN_EPI) { if (wr == 1) PG8_BAR; }
    }
    PG8_WAIT_V(0);
    if constexpr (!ALIGN_EPI) { if (wr == 0) PG8_BAR; }
    PG8_BAR;
    if constexpr (Epi::AFTER_DRAIN) { E.fused(acc, cur, wr, wc, fr, fq, lds, wid, lane); S.done(cur); }
#undef PG8_SA
#undef PG8_SB
#undef PG8_STAGE
#undef PG8_LDA
#undef PG8_LDB
#undef PG8_MMA
#undef PG8_WAIT_V
#undef PG8_WAIT_L
#undef PG8_BAR
#undef PG8_SCHED
}
}

constexpr size_t MiB = 1u << 20;
constexpr size_t WS_CTL = 0, CTL_ZERO_BYTES = 3 * MiB;
constexpr size_t WS_SS = 256 * 1024;
static_assert(WS_SS + 9 * (size_t)MP * 8 <= CTL_ZERO_BYTES, "ctl map");
constexpr size_t WS_WT = 3 * MiB;
constexpr size_t WT_IN = 0, WT_OUT = (size_t)NINP * D, WT_UP = WT_OUT + (size_t)DI * D, WT_DOWN = WT_UP + (size_t)NUP * D, WT_ELEMS = WT_DOWN + (size_t)D * DFF;
constexpr size_t WT_BUF_BYTES = 124 * MiB;
constexpr size_t WS_H = WS_WT + 2 * WT_BUF_BYTES;
constexpr size_t H_PAD = 4 * (size_t)D * 2;
constexpr size_t WS_BIG = WS_H + 138 * MiB;
constexpr size_t WS_END = WS_BIG + 697 * MiB;
static_assert(WT_ELEMS * 2 <= 124 * MiB && H_PAD + (size_t)MP * D * 2 <= 138 * MiB, "ws map");
constexpr size_t BIG_BG = 0, BIG_CV = 138 * MiB, BIG_G = 412 * MiB;
static_assert((size_t)MP * D * 2 <= 138 * MiB && BIG_G + (size_t)MP * D * 2 <= 694 * MiB, "sc overlay");
constexpr size_t BIG_Z = 0, BIG_XBC = 274 * MiB, BIG_DT = BIG_XBC + 411 * MiB, BIG_RAWB = BIG_DT + 9 * MiB;
static_assert((size_t)MP * DI * 2 <= 274 * MiB && (size_t)MP * CONVD * 2 <= 411 * MiB && BIG_DT + (size_t)MP * NH * 4 <= BIG_RAWB && BIG_RAWB + (size_t)(NB + NS) * 3 * CONVD * 4 <= 697 * MiB, "ssd overlay");
constexpr size_t BIG_ACT = 0;
constexpr size_t BIG_SKP = 560 * MiB, SKP_BYTES = (size_t)255 * 2 * 256 * 256 * 4;
static_assert(BIG_G + (size_t)MP * D * 2 <= BIG_SKP && (size_t)MP * DI * 2 <= BIG_SKP && (size_t)MP * DFF * 2 <= BIG_SKP && BIG_SKP + SKP_BYTES <= 697 * MiB, "split-K scratch");
constexpr size_t SSG_OFF = 64 * MiB;
static_assert((size_t)128 * 2 * 256 * 256 * 4 <= SSG_OFF && SSG_OFF + (size_t)8 * MP * 8 <= WT_BUF_BYTES, "ssg");
constexpr size_t CTL_SKF = 32 * 1024; constexpr int SKF_WORDS = 128 * 64;
constexpr int SSD_ROW_TILES = 140;
static_assert(SSD_ROW_TILES * 250 >= T && SSD_ROW_TILES * 250 + 3 <= MP, "ssd tiles");
constexpr int FFN_ROW_TILES = 139;
static_assert((size_t)MP * DFF * 2 <= 694 * MiB && FFN_ROW_TILES * 252 >= T && FFN_ROW_TILES * 252 + 2 <= MP, "ffn overlay");
constexpr int CW_BAR = 4096;
static_assert((size_t)(CW_BAR + 3456) * 4 <= CTL_SKF && CTL_SKF + (size_t)7 * SKF_WORDS * 4 <= WS_SS, "ctl map");

constexpr int RING_OFF = 0, RING_BYTES = 131072;
constexpr int LDS_BYTES = 163840;
constexpr int LDSCTL_OFF = LDS_BYTES - 1024, MISC_OFF = LDSCTL_OFF + 320;
constexpr int EPI_WL_OFF = RING_BYTES;
constexpr int NWAVES = 8;

#define RLX_AGENT __ATOMIC_RELAXED, __HIP_MEMORY_SCOPE_AGENT
#define LDS_WAIT() asm volatile("s_waitcnt lgkmcnt(0)" ::: "memory")
#define VM_WAIT() asm volatile("s_waitcnt vmcnt(0)" ::: "memory")
typedef GAS unsigned gu32;

#define XB_TMO      128
#define XB_XCNT(j)  (256  + 64 * (j))
#define XB_XSUB(j)  (1280 + 64 * (j))
#define XB_XGEN(j)  (2304 + 64 * (j))
#define XB_TOP      3328
#define XB_TOPGEN   3392
#define XCD_BAR_WORDS 3456
#define XB_SPIN_CAP (1u << 18)

__device__ __forceinline__ unsigned xb_ld(unsigned* p)              { return __hip_atomic_load(p, __ATOMIC_RELAXED, __HIP_MEMORY_SCOPE_AGENT); }
__device__ __forceinline__ unsigned xb_add(unsigned* p, unsigned v) { return __hip_atomic_fetch_add(p, v, __ATOMIC_RELAXED, __HIP_MEMORY_SCOPE_AGENT); }
__device__ __forceinline__ unsigned xb_xcc_id() { return (unsigned)__builtin_amdgcn_s_getreg((3 << 11) | 20) & 0xFu; }
#define XB_SPIN(cond, bar) do { unsigned _sp = 0; while (cond) { __builtin_amdgcn_s_sleep(1); \
    if ((++_sp & 255u) == 0u) { if (xb_ld(&(bar)[XB_TMO])) break; if (_sp > XB_SPIN_CAP) { atomicAdd(&(bar)[XB_TMO], 1u); break; } } } } while (0)

struct XcdBarrier {
    unsigned* bar; unsigned x;
    volatile LAS unsigned* st;
};

__device__ __forceinline__ XcdBarrier xcd_barrier_post(unsigned* bar, volatile LAS unsigned* st) {
    XcdBarrier b; b.bar = bar; b.x = xb_xcc_id(); b.st = st;
    if (threadIdx.x == 0) (void)xb_add(&bar[XB_XCNT(b.x)], 1u);
    return b;
}
__device__ __forceinline__ void xcd_barrier_complete(unsigned* bar, unsigned x, unsigned& nloc, unsigned& nx) {
    const unsigned G = gridDim.x * gridDim.y * gridDim.z;
    unsigned sum, cnt, mine, sp = 0u;
    for (;;) {
        sum = 0u; cnt = 0u; mine = 0u;
#pragma unroll
        for (unsigned j = 0; j < 16; ++j) { const unsigned c = xb_ld(&bar[XB_XCNT(j)]); sum += c; cnt += (c > 0u) ? 1u : 0u; mine = (j == x) ? c : mine; }
        if (sum == G) break;
        __builtin_amdgcn_s_sleep(1);
        if ((++sp & 255u) == 0u) { if (xb_ld(&bar[XB_TMO])) break; if (sp > XB_SPIN_CAP) { atomicAdd(&bar[XB_TMO], 1u); break; } }
    }
    nloc = mine > 0u ? mine : 1u; nx = cnt > 0u ? cnt : 1u;
}

__device__ __forceinline__ void xcd_barrier(const XcdBarrier& b) {
    asm volatile("s_waitcnt vmcnt(0)" ::: "memory");
    __syncthreads();
    if (threadIdx.x == 0) {
        unsigned* bar = b.bar; asm volatile("" : "+s"(bar));
        unsigned bx = b.x; asm volatile("" : "+s"(bx));
        __builtin_amdgcn_s_waitcnt(0);
        unsigned nloc = b.st[0], nx = b.st[1];
        if (nloc == 0u) { xcd_barrier_complete(bar, bx, nloc, nx); b.st[0] = nloc; b.st[1] = nx; }
        const unsigned old = xb_add(&bar[XB_XSUB(bx)], 1u);
        const unsigned gen = old / nloc;
        if (old + 1u == (gen + 1u) * nloc) {
            __builtin_amdgcn_fence(__ATOMIC_RELEASE, "agent");
            asm volatile("s_waitcnt vmcnt(0)" ::: "memory");
            const unsigned og = xb_add(&bar[XB_TOP], 1u);
            const unsigned tg = og / nx;
            if (og + 1u == (tg + 1u) * nx) xb_add(&bar[XB_TOPGEN], 1u);
            else XB_SPIN(xb_ld(&bar[XB_TOPGEN]) == tg, bar);
            __builtin_amdgcn_fence(__ATOMIC_ACQUIRE, "agent");
            xb_add(&bar[XB_XGEN(bx)], 1u);
            asm volatile("s_waitcnt vmcnt(0)" ::: "memory");
        } else {
            XB_SPIN(xb_ld(&bar[XB_XGEN(bx)]) == gen, bar);
            __builtin_amdgcn_fence(__ATOMIC_ACQUIRE, "agent");
            asm volatile("s_waitcnt vmcnt(0)" ::: "memory");
        }
    }
    __syncthreads();
}


struct Params { const float* in[N_IN]; float* out; unsigned char* ws; };
struct Ctx {
    LAS unsigned char* lds;
    int tid, lane, wave, vcu, G;
};
__device__ __forceinline__ const float* ldp(const float* p) { asm volatile("" : "+s"(p)); return p; }
__device__ __forceinline__ Ctx refresh(const Ctx& F0) { Ctx F = F0; F.tid = opaque_i((int)threadIdx.x); F.lane = F.tid & 63; F.wave = __builtin_amdgcn_readfirstlane(F.tid >> 6); return F; }

__device__ __forceinline__ float wave_sum(float v, int lane) {
#pragma unroll
    for (int o = 1; o < 64; o <<= 1) v += shfl_from(v, lane ^ o);
    return v;
}

struct RowInfo { int seq, pos, L; bool sample; };
__device__ __forceinline__ RowInfo row_info(int r) {
    RowInfo ri;
    if (r < TP) { ri.sample = false; ri.seq = r / LP; ri.pos = r - ri.seq * LP; ri.L = LP; }
    else { const int q = r - TP; ri.sample = true; ri.seq = q >> 6; ri.pos = q & 63; ri.L = LS; }
    return ri;
}

template <int MODE = 0> __device__ __forceinline__ void transpose_item(const float* W, int K, int N, bf16* WT, const float* rowscale, LAS float* scr, int item, int lane) {
    const int nblk = N / 32, kb = item / nblk, nb = item - kb * nblk, k0 = 64 * kb, n0 = 32 * nb;
    const int d0 = MODE == 0 ? n0 : MODE == 1 ? (n0 < DFF ? 256 * (n0 >> 7) + (n0 & 127) : 256 * ((n0 - DFF) >> 7) + 128 + ((n0 - DFF) & 127))
                             : (n0 < D ? n0 : n0 < 2 * D ? D + 256 * ((n0 - D) >> 7) + ((n0 - D) & 127) : D + 256 * ((n0 - 2 * D) >> 7) + 128 + ((n0 - 2 * D) & 127));
    const int lr = lane >> 3, lc = (lane & 7) * 4;
    f32x4 v[8];
#pragma unroll
    for (int i = 0; i < 8; ++i) v[i] = *(const f32x4*)(W + (size_t)(k0 + lr + 8 * i) * N + n0 + lc);
    if (rowscale) {
#pragma unroll
        for (int i = 0; i < 8; ++i) v[i] = v[i] * rowscale[k0 + lr + 8 * i];
    }
#pragma unroll
    for (int i = 0; i < 8; ++i) { LAS float* d = scr + (lr + 8 * i) * 33 + lc; d[0] = v[i].x; d[1] = v[i].y; d[2] = v[i].z; d[3] = v[i].w; }
    LDS_WAIT(); asm volatile("" ::: "memory");
    const int c = lane & 7;
#pragma unroll
    for (int j = 0; j < 4; ++j) { const int n = (lane >> 3) + 8 * j; const LAS float* s = scr + (8 * c) * 33 + n;
        v4u o; o.x = pk2(s[0 * 33], s[1 * 33]); o.y = pk2(s[2 * 33], s[3 * 33]); o.z = pk2(s[4 * 33], s[5 * 33]); o.w = pk2(s[6 * 33], s[7 * 33]);
        *(v4u*)(WT + (size_t)(d0 + n) * K + k0 + 8 * c) = o; }
    LDS_WAIT(); asm volatile("" ::: "memory");
}
__device__ __forceinline__ void convert_layer_weights(const Ctx& F0, const Params& P, int layer, int wg0) {
    if ((int)blockIdx.x < wg0) return;
    const Ctx F = refresh(F0);
    LAS float* scr = (LAS float*)(F.lds + RING_OFF + F.wave * 16384);
    bf16* WT = (bf16*)(P.ws + WS_WT + (size_t)(layer & 1) * WT_BUF_BYTES);
    const int gw = ((int)blockIdx.x - wg0) * NWAVES + F.wave, NGW = (F.G - wg0) * NWAVES;
    const int j = layer >> 1; const bool ssd = layer & 1;
    const float* p_ssd_in = ldp(P.in[I_SSD_WIN]); const float* p_sc_in = ldp(P.in[I_SC_WIN]); const float* p_ssd_out = ldp(P.in[I_SSD_WOUT]); const float* p_sc_out = ldp(P.in[I_SC_WOUT]);
    const float* w_in  = ssd ? p_ssd_in + (size_t)j * D * NIN : p_sc_in + (size_t)j * D * 3 * D;
    const float* w_out = ssd ? p_ssd_out + (size_t)j * DI * D : p_sc_out + (size_t)j * D * D;
    const float* w_up = P.in[I_FFN_WUP] + (size_t)layer * D * NUP;
    const float* w_dn = P.in[I_FFN_WDOWN] + (size_t)layer * DFF * D;
    const float* g_ssdn = P.in[I_SSD_NW] + (size_t)j * DI;
    const float* g_mix = P.in[I_NMIX] + (size_t)layer * D; const float* g_ffn = P.in[I_NFFN] + (size_t)layer * D;
    const int n_in = ssd ? NIN : 3 * D, k_out = ssd ? DI : D;
    const int it_in = (D / 64) * (n_in / 32), it_out = (k_out / 64) * (D / 32), it_up = (D / 64) * (NUP / 32), it_dn = (DFF / 64) * (D / 32);
    const int total = it_in + it_out + it_up + it_dn;
    for (int it = gw; it < total; it += NGW) {
        int r = it;
        if (r < it_in) { if (ssd) transpose_item<0>(w_in, D, n_in, WT + WT_IN, g_mix, scr, r, F.lane); else transpose_item<2>(w_in, D, n_in, WT + WT_IN, g_mix, scr, r, F.lane); continue; } r -= it_in;
        if (r < it_out) { transpose_item(w_out, k_out, D, WT + WT_OUT, ssd ? g_ssdn : nullptr, scr, r, F.lane); continue; } r -= it_out;
        if (r < it_up) { transpose_item<1>(w_up, D, NUP, WT + WT_UP, g_ffn, scr, r, F.lane); continue; } r -= it_up;
        transpose_item(w_dn, DFF, D, WT + WT_DOWN, nullptr, scr, r, F.lane);
    }
    if (ssd) {
        const int gt = gw * 64 + F.lane, NT = NGW * 64; const unsigned zz = __builtin_bit_cast(unsigned, opaque_zero()); v4u z = {zz, zz, zz, zz};
        v4u* pz = (v4u*)(WT + WT_IN + (size_t)NIN * D);
        for (int i = gt; i < (NINP - NIN) * D / 8; i += NT) pz[i] = z;
    }
}

__device__ __forceinline__ const float* src_row0(const Params& P, int r) {
    if (r < TP) { const int b = r / LP, pos = r - b * LP;
        return pos < NMETA ? P.in[I_META] + (size_t)pos * D : P.in[I_XP] + ((size_t)b * SEQ + (pos - NMETA)) * D; }
    return P.in[I_XS] + (size_t)(r - TP) * D;
}
__device__ __forceinline__ void embed_phase(const Ctx& F0, const Params& P) {
    const Ctx F = refresh(F0);
    bf16* H = (bf16*)(P.ws + WS_H + H_PAD); unsigned long long* ss = (unsigned long long*)(P.ws + WS_SS);
    const int gw = F.vcu * NWAVES + F.wave, NGW = F.G * NWAVES;
    for (int m = gw; m < MP; m += NGW) {
        v2u* ho = (v2u*)(H + (size_t)m * D);
        if (m < T) {
            const f32x4* xr = (const f32x4*)src_row0(P, m);
            f32x4 v[8]; float s = 0.f;
#pragma unroll
            for (int j = 0; j < 8; ++j) v[j] = xr[F.lane + 64 * j];
#pragma unroll
            for (int j = 0; j < 8; ++j) { v2u q; q.x = pk2(v[j].x, v[j].y); q.y = pk2(v[j].z, v[j].w); ho[F.lane + 64 * j] = q;
                const float r0 = bflo(q.x), r1 = bfhi(q.x), r2 = bflo(q.y), r3 = bfhi(q.y); s += (r0 * r0 + r1 * r1) + (r2 * r2 + r3 * r3); }
            s = wave_sum(s, F.lane);
            if (F.lane == 0) ss[m] = (unsigned long long)(s * 1048576.0f + 0.5f);
        } else {
            const unsigned zu = __builtin_bit_cast(unsigned, opaque_zero());
#pragma unroll
            for (int j = 0; j < 8; ++j) ho[F.lane + 64 * j] = (v2u){zu, zu};
        }
    }
}
__device__ __forceinline__ void final_norm_phase(const Ctx& F0, const Params& P) {
    const Ctx F = refresh(F0);
    const bf16* H = (const bf16*)(P.ws + WS_H + H_PAD); const float* w = P.in[I_NFINAL];
    const int gw = F.vcu * NWAVES + F.wave, NGW = F.G * NWAVES;
    f32x4 wv[8];
#pragma unroll
    for (int j = 0; j < 8; ++j) wv[j] = ((const f32x4*)w)[F.lane + 64 * j];
    for (int m = gw; m < T; m += NGW) {
        float* orow;
        if (m < TP) { const int b = m / LP, pos = m - b * LP; if (pos < NMETA) continue; orow = P.out + O_YP + ((size_t)b * SEQ + (pos - NMETA)) * D; }
        else orow = P.out + O_YS + (size_t)(m - TP) * D;
        const v2u* xr = (const v2u*)(H + (size_t)m * D);
        f32x4 v[8]; float s = 0.f;
#pragma unroll
        for (int j = 0; j < 8; ++j) { const v2u q = xr[F.lane + 64 * j]; v[j] = (f32x4){bflo(q.x), bfhi(q.x), bflo(q.y), bfhi(q.y)}; s += (v[j].x * v[j].x + v[j].y * v[j].y) + (v[j].z * v[j].z + v[j].w * v[j].w); }
        const float rstd = 1.0f / sqrtf(wave_sum(s, F.lane) * (1.0f / D) + EPS);
#pragma unroll
        for (int j = 0; j < 8; ++j) ((f32x4*)orow)[F.lane + 64 * j] = v[j] * rstd * wv[j];
    }
}

__device__ __forceinline__ void unpack8(const v4u q, float (&f)[8]) {
    f[0] = bflo(q.x); f[1] = bfhi(q.x); f[2] = bflo(q.y); f[3] = bfhi(q.y); f[4] = bflo(q.z); f[5] = bfhi(q.z); f[6] = bflo(q.w); f[7] = bfhi(q.w);
}
__device__ __forceinline__ void sc_gate_phase(const Ctx& F0, const Params& P, int j) {
    const Ctx F = refresh(F0);
    const bf16* BG = (const bf16*)(P.ws + WS_BIG + BIG_BG); const bf16* CV = (const bf16*)(P.ws + WS_BIG + BIG_CV); bf16* G = (bf16*)(P.ws + WS_BIG + BIG_G);
    const float* cw = P.in[I_SC_CW] + (size_t)j * 3 * D;
    const float* st = P.in[I_ST_CONVA] + (size_t)j * NS * 2 * D;
    const int gt = (F.vcu * NWAVES + F.wave) * 64 + F.lane, NT = F.G * NWAVES * 64;
    static_assert(LP % 4 == 0 && LS % 4 == 0 && TP % 4 == 0 && T % 4 == 0, "4-row strips");
    for (int idx = gt; idx < (T / 4) * 256; idx += NT) {
        const int r0 = (idx >> 8) * 4, c0 = (idx & 255) * 8;
        const RowInfo ri = row_info(r0);
        const int rm2 = max(r0 - 2, 0);
        v4u qb[4], qc[6];
#pragma unroll
        for (int i = 0; i < 4; ++i) qb[i] = *(const v4u*)(BG + (size_t)(r0 + i) * D + c0);
#pragma unroll
        for (int i = 0; i < 6; ++i) qc[i] = *(const v4u*)(CV + (size_t)(rm2 + i) * D + c0);
        const f32x4 w0l = *(const f32x4*)(cw + c0), w0h = *(const f32x4*)(cw + c0 + 4), w1l = *(const f32x4*)(cw + D + c0), w1h = *(const f32x4*)(cw + D + c0 + 4), w2l = *(const f32x4*)(cw + 2 * D + c0), w2h = *(const f32x4*)(cw + 2 * D + c0 + 4);
        const float w0[8] = {w0l[0], w0l[1], w0l[2], w0l[3], w0h[0], w0h[1], w0h[2], w0h[3]}, w1[8] = {w1l[0], w1l[1], w1l[2], w1l[3], w1h[0], w1h[1], w1h[2], w1h[3]}, w2[8] = {w2l[0], w2l[1], w2l[2], w2l[3], w2h[0], w2h[1], w2h[2], w2h[3]};
        float cv[6][8];
#pragma unroll
        for (int i = 0; i < 6; ++i) unpack8(qc[i], cv[i]);
        if (r0 < 2) {
#pragma unroll
            for (int i = 5; i >= 2; --i)
#pragma unroll
                for (int e = 0; e < 8; ++e) cv[i][e] = cv[i - 2][e];
        }
        if (ri.pos == 0) {
            if (ri.sample) { const float* s = st + (size_t)ri.seq * 2 * D + c0;
#pragma unroll
                for (int e = 0; e < 8; ++e) { cv[0][e] = s[e]; cv[1][e] = s[D + e]; } }
            else {
#pragma unroll
                for (int e = 0; e < 8; ++e) { cv[0][e] = 0.f; cv[1][e] = 0.f; } }
        }
#pragma unroll
        for (int i = 0; i < 4; ++i) {
            float bg[8], g[8]; unpack8(qb[i], bg);
#pragma unroll
            for (int e = 0; e < 8; ++e) g[e] = bg[e] * (w0[e] * cv[i][e] + w1[e] * cv[i + 1][e] + w2[e] * cv[i + 2][e]);
            v4u o; o.x = pk2(g[0], g[1]); o.y = pk2(g[2], g[3]); o.z = pk2(g[4], g[5]); o.w = pk2(g[6], g[7]);
            *(v4u*)(G + (size_t)(r0 + i) * D + c0) = o;
        }
        if (ri.pos == ri.L - 4) {
#pragma unroll
            for (int k = 0; k < 2; ++k) {
                float* ob = ri.sample ? P.out + O_SCONVA + (((size_t)j * NS + ri.seq) * 2 + k) * D + c0 : P.out + O_PCONVA + (((size_t)j * NB + ri.seq) * 2 + k) * D + c0;
                *(f32x4*)ob = (f32x4){cv[4 + k][0], cv[4 + k][1], cv[4 + k][2], cv[4 + k][3]}; *(f32x4*)(ob + 4) = (f32x4){cv[4 + k][4], cv[4 + k][5], cv[4 + k][6], cv[4 + k][7]};
            }
        }
    }
}


constexpr int SC_TILE = 53248;
constexpr int SC_X = 0, SC_XW = 9216, SC_B = 18432, SC_C = 35840;
constexpr int SC_S = 2 * SC_TILE;
constexpr int SC_PB = SC_S + 2 * 17408;
constexpr int SC_DT = SC_PB + 9216;
constexpr int SC_END = SC_DT + 3 * 1024;
static_assert(SC_END <= LDSCTL_OFF, "scan LDS");
#define SCAN_BAR() do { asm volatile("s_waitcnt lgkmcnt(0)" ::: "memory"); __builtin_amdgcn_s_barrier(); asm volatile("" ::: "memory"); } while (0)
#define MFMA32(a, b, c) __builtin_amdgcn_mfma_f32_32x32x16_bf16((a), (b), (c), 0, 0, 0)
typedef short s16x4 __attribute__((ext_vector_type(4)));

__device__ __forceinline__ bf16x8 mk8s(s16x4 a, s16x4 b) { return __builtin_shufflevector(a, b, 0, 1, 2, 3, 4, 5, 6, 7); }
__device__ __forceinline__ s16x4 tr_read(LAS unsigned char* p) { return __builtin_amdgcn_ds_read_tr16_b64_v4i16((LAS s16x4*)p); }

__device__ __forceinline__ void ssd_scan_phase(const Ctx& F0, const Params& P, int j2, bool dry, unsigned long long* ssg) {
    const Ctx F = refresh(F0);
    LAS unsigned char* lds = F.lds + RING_OFF;
    bf16* Z = (bf16*)(P.ws + WS_BIG + BIG_Z); const bf16* XBC = (const bf16*)(P.ws + WS_BIG + BIG_XBC); const float* DT = (const float*)(P.ws + WS_BIG + BIG_DT);
    const int wave = F.wave;

    for (int ch = F.vcu; ch < NB * NH + NS * NH; ch += F.G) {
        const int tid = opaque_i(F.tid), lane = tid & 63, r = lane & 31, h = lane >> 5;
        const bool sample = ch >= NB * NH;
        const int cidx = sample ? ch - NB * NH : ch;
        const int b = cidx >> 6, hd = cidx & 63, g = hd >> 3;
        const int L = sample ? LS : LP, row0 = sample ? TP + b * LS : b * LP;
        const int nchunks = (L + 63) >> 6;
        const float Ah = -__expf(P.in[I_SSD_ALOG][j2 * NH + hd]), Dh = P.in[I_SSD_D][j2 * NH + hd];
        const int wq = wave & 3, pbY = wq >> 1, ibY = wq & 1;

        __syncthreads();
        f32x16 sacc[2];
#pragma unroll
        for (int pb = 0; pb < 2; ++pb)
#pragma unroll
            for (int i = 0; i < 16; ++i) sacc[pb][i] = 0.f;
        if (wave >= 4) {
            const int nb = wq;
            if (sample) {
                const float* s0 = P.in[I_ST_SSD] + (((size_t)j2 * NS + b) * NH + hd) * (HD * NST);
#pragma unroll
                for (int pb = 0; pb < 2; ++pb)
#pragma unroll
                    for (int q = 0; q < 4; ++q) { const f32x4 v = *(const f32x4*)(s0 + (size_t)(32 * pb + r) * NST + 32 * nb + 8 * q + 4 * h);
                        sacc[pb][4 * q] = v.x; sacc[pb][4 * q + 1] = v.y; sacc[pb][4 * q + 2] = v.z; sacc[pb][4 * q + 3] = v.w; }
            }
#pragma unroll
            for (int pb = 0; pb < 2; ++pb)
#pragma unroll
                for (int q = 0; q < 4; ++q) { v2u w; w.x = pk2(sacc[pb][4 * q], sacc[pb][4 * q + 1]); w.y = pk2(sacc[pb][4 * q + 2], sacc[pb][4 * q + 3]);
                    *(LAS v2u*)(lds + SC_S + 17408 + (32 * pb + r) * 272 + (32 * nb + 8 * q + 4 * h) * 2) = w; }
        }
        auto dt_calc = [&](int c, float raw) {
            const float dtv = (64 * c + lane < L) ? raw : 0.f;
            float a = dtv * Ah;
#pragma unroll
            for (int o = 1; o < 64; o <<= 1) { const float t = shfl_from(a, (lane - o) & 63); a += (lane >= o) ? t : 0.f; }
            const float last = shfl_from(a, 63);
            LAS float* db = (LAS float*)(lds + SC_DT + (c % 3) * 1024);
            db[lane] = a; db[64 + lane] = dtv; db[128 + lane] = __expf(last - a) * dtv;
            if (lane == 0) db[192] = __expf(last);
        };
        auto dt_load = [&](int c) -> float {
            const int pos = 64 * c + lane; return DT[(size_t)(row0 + min(pos, L - 1)) * NH + hd];
        };
        { const float d0 = dt_load(0), d1 = dt_load(min(1, nchunks - 1));
          if (wave == 3) { dt_calc(0, d0); if (nchunks > 1) dt_calc(1, d1); } }
        float dtr = dt_load(min(2, nchunks - 1));

        v4u gx, gb0, gb1, gc0, gc1;
        const int xrow = tid >> 3, xch = tid & 7, brow = tid >> 4, bch = tid & 15;
        const char* ub = (const char*)XBC + (size_t)row0 * (CONVD * 2);
        const unsigned vox = (unsigned)(xrow * CONVD + hd * 64 + 8 * xch) * 2u, vob = (unsigned)(brow * CONVD + DI + g * 128 + 8 * bch) * 2u;
        auto prefetch = [&](int c) {
            const char* uc = ub + (size_t)c * (64 * CONVD * 2);
            gx = *(const v4u*)(uc + vox);
            gb0 = *(const v4u*)(uc + vob); gc0 = *(const v4u*)(uc + vob + NG * NST * 2);
            gb1 = *(const v4u*)(uc + 32 * (CONVD * 2) + vob); gc1 = *(const v4u*)(uc + 32 * (CONVD * 2) + vob + NG * NST * 2);
        };
        auto stage = [&](int c) {
            LAS unsigned char* tb = lds + (c & 1) * SC_TILE;
            const LAS float* dbc = (const LAS float*)(lds + SC_DT + (c % 3) * 1024);
            const v4u zero4 = {0u, 0u, 0u, 0u};
            if (64 * c + xrow >= L) gx = zero4;
            if (64 * c + brow >= L) { gb0 = zero4; gc0 = zero4; }
            if (64 * c + brow + 32 >= L) { gb1 = zero4; gc1 = zero4; }
            *(LAS v4u*)(tb + SC_X + xrow * 144 + 16 * xch) = gx;
            const float wt = dbc[128 + xrow];
            v4u xw; xw.x = pk2(bflo(gx.x) * wt, bfhi(gx.x) * wt); xw.y = pk2(bflo(gx.y) * wt, bfhi(gx.y) * wt); xw.z = pk2(bflo(gx.z) * wt, bfhi(gx.z) * wt); xw.w = pk2(bflo(gx.w) * wt, bfhi(gx.w) * wt);
            *(LAS v4u*)(tb + SC_XW + xrow * 144 + 16 * xch) = xw;
            *(LAS v4u*)(tb + SC_B + brow * 272 + 16 * bch) = gb0; *(LAS v4u*)(tb + SC_B + (brow + 32) * 272 + 16 * bch) = gb1;
            *(LAS v4u*)(tb + SC_C + brow * 272 + 16 * bch) = gc0; *(LAS v4u*)(tb + SC_C + (brow + 32) * 272 + 16 * bch) = gc1;
        };
        prefetch(0);
        v2u zn[4];
        {
            const int pos = min(32 * ibY + r, L - 1);
            const bf16* zr = Z + (size_t)(row0 + pos) * DI + hd * 64 + 32 * pbY + 4 * h;
#pragma unroll
            for (int q = 0; q < 4; ++q) zn[q] = *(const v2u*)(zr + 8 * q);
        }
        {
            const float* cwp = P.in[I_SSD_CW] + (size_t)j2 * 4 * CONVD; const float* cbp = P.in[I_SSD_CB] + (size_t)j2 * CONVD;
            const float* stc = P.in[I_ST_SSDCONV] + ((size_t)j2 * NS + b) * 3 * CONVD;
            const float* rawq = (const float*)(P.ws + WS_BIG + BIG_RAWB) + (size_t)(sample ? NB + b : b) * 3 * CONVD;
            auto fix8 = [&](int pos, int col0) -> v4u {
                f32x4 rw[4][2], sw[4][2], ww[4][2], bb[2];
#pragma unroll
                for (int k = 0; k < 4; ++k) {
                    const int p = pos - 3 + k, pr = max(p, 0), ps = min(max(3 + p, 0), 2);
#pragma unroll
                    for (int hh = 0; hh < 2; ++hh) {
                        rw[k][hh] = *(const f32x4*)(rawq + (size_t)pr * CONVD + col0 + 4 * hh);
                        sw[k][hh] = *(const f32x4*)(stc + (size_t)ps * CONVD + col0 + 4 * hh);
                        ww[k][hh] = *(const f32x4*)(cwp + (size_t)k * CONVD + col0 + 4 * hh);
                    }
                }
                bb[0] = *(const f32x4*)(cbp + col0); bb[1] = *(const f32x4*)(cbp + col0 + 4);
                float o[8];
#pragma unroll
                for (int e = 0; e < 8; ++e) {
                    float s = bb[e >> 2][e & 3];
#pragma unroll
                    for (int k = 0; k < 4; ++k) { const int p = pos - 3 + k; const float v = (p >= 0) ? rw[k][e >> 2][e & 3] : (sample ? sw[k][e >> 2][e & 3] : 0.f); s += ww[k][e >> 2][e & 3] * v; }
                    o[e] = silu_f(s);
                }
                v4u w; w.x = pk2(o[0], o[1]); w.y = pk2(o[2], o[3]); w.z = pk2(o[4], o[5]); w.w = pk2(o[6], o[7]); return w;
            };
            if (xrow < 3) gx = fix8(xrow, hd * 64 + 8 * xch);
            if (brow < 3) { gb0 = fix8(brow, DI + g * 128 + 8 * bch); gc0 = fix8(brow, DI + NG * NST + g * 128 + 8 * bch); }
        }
        __syncthreads();
        stage(0);
        prefetch(min(1, nchunks - 1));
        SCAN_BAR();

        const int g16 = (lane >> 4) & 1, li = lane & 15, tq = li >> 2, tp = li & 3;
        for (int c = 0; c < nchunks; ++c) {
            const LAS float* db = (const LAS float*)(lds + SC_DT + (c % 3) * 1024);
            LAS unsigned char* tb = lds + (c & 1) * SC_TILE;
            if (c + 1 < nchunks) stage(c + 1);
            prefetch(min(c + 2, nchunks - 1));
            f32x16 y2;
#pragma unroll
            for (int i = 0; i < 16; ++i) y2[i] = 0.f;
            if (wave < 3) {
                const int jb = wave >> 1, ib = (wave + 1) >> 1;
                f32x16 gt;
#pragma unroll
                for (int i = 0; i < 16; ++i) gt[i] = 0.f;
#pragma unroll
                for (int s = 0; s < 8; ++s) {
                    const bf16x8 a = *(const LAS bf16x8*)(tb + SC_B + (32 * jb + r) * 272 + (16 * s + 8 * h) * 2);
                    const bf16x8 cfr = *(const LAS bf16x8*)(tb + SC_C + (32 * ib + r) * 272 + (16 * s + 8 * h) * 2);
                    gt = MFMA32(a, cfr, gt);
                }
                const int tok = 32 * ib + r; const float cs_i = db[tok];
#pragma unroll
                for (int q = 0; q < 4; ++q) {
                    const int j0 = 32 * jb + 8 * q + 4 * h;
                    const f32x4 csj = *(const LAS f32x4*)(db + j0), dtj = *(const LAS f32x4*)(db + 64 + j0);
                    float pv[4];
#pragma unroll
                    for (int e = 0; e < 4; ++e) {
                        const int jj = j0 + e;
                        float v = gt[4 * q + e] * __expf(fminf(cs_i - csj[e], 0.f)) * dtj[e];
                        v = (jj <= tok) ? v : 0.f;
                        v += (jj == tok) ? Dh : 0.f;
                        pv[e] = v;
                    }
                    v2u w; w.x = pk2(pv[0], pv[1]); w.y = pk2(pv[2], pv[3]);
                    *(LAS v2u*)(lds + SC_PB + tok * 144 + j0 * 2) = w;
                }
            } else if (wave == 3) {
                if (c + 2 < nchunks) dt_calc(c + 2, dtr);
            } else {
                const int nb = wq;
                const int sbuf = (c + 1) & 1;
#pragma unroll
                for (int s = 0; s < 8; ++s) {
                    const bf16x8 a = *(const LAS bf16x8*)(lds + SC_S + sbuf * 17408 + (32 * pbY + r) * 272 + (16 * s + 8 * h) * 2);
                    const bf16x8 cfr = *(const LAS bf16x8*)(tb + SC_C + (32 * ibY + r) * 272 + (16 * s + 8 * h) * 2);
                    y2 = MFMA32(a, cfr, y2);
                }
                const float dS = db[192];
#pragma unroll
                for (int pb = 0; pb < 2; ++pb)
#pragma unroll
                    for (int i = 0; i < 16; ++i) sacc[pb][i] *= dS;
#pragma unroll
                for (int s = 0; s < 4; ++s) {
                    const int R0 = 16 * s + 8 * h;
                    LAS unsigned char* ba = tb + SC_B + (R0 + tq) * 272 + (32 * nb + 16 * g16 + 4 * tp) * 2;
                    const bf16x8 af = mk8s(tr_read(ba), tr_read(ba + 4 * 272));
#pragma unroll
                    for (int pb = 0; pb < 2; ++pb) {
                        LAS unsigned char* xb = tb + SC_XW + (R0 + tq) * 144 + (32 * pb + 16 * g16 + 4 * tp) * 2;
                        sacc[pb] = MFMA32(af, mk8s(tr_read(xb), tr_read(xb + 4 * 144)), sacc[pb]);
                    }
                }
                const int wbuf = c & 1;
#pragma unroll
                for (int pb = 0; pb < 2; ++pb)
#pragma unroll
                    for (int q = 0; q < 4; ++q) { v2u w; w.x = pk2(sacc[pb][4 * q], sacc[pb][4 * q + 1]); w.y = pk2(sacc[pb][4 * q + 2], sacc[pb][4 * q + 3]);
                        *(LAS v2u*)(lds + SC_S + wbuf * 17408 + (32 * pb + r) * 272 + (32 * nb + 8 * q + 4 * h) * 2) = w; }
            }
            dtr = dt_load(min(c + 3, nchunks - 1));
            SCAN_BAR();
            if (wave >= 4) {
                const int tok = 32 * ibY + r, pos = 64 * c + tok; const bool valid = pos < L;
                bf16* zrow = Z + (size_t)(row0 + pos) * DI + hd * 64 + 32 * pbY + 4 * h;
                f32x16 y1;
#pragma unroll
                for (int i = 0; i < 16; ++i) y1[i] = 0.f;
#pragma unroll
                for (int jb = 0; jb < 2; ++jb) {
                    if (jb <= ibY) {
#pragma unroll
                        for (int s2 = 0; s2 < 2; ++s2) {
                            const int R0 = 32 * jb + 16 * s2 + 8 * h;
                            LAS unsigned char* xa = tb + SC_X + (R0 + tq) * 144 + (32 * pbY + 16 * g16 + 4 * tp) * 2;
                            const bf16x8 af = mk8s(tr_read(xa), tr_read(xa + 4 * 144));
                            const bf16x8 pf = *(const LAS bf16x8*)(lds + SC_PB + tok * 144 + R0 * 2);
                            y1 = MFMA32(af, pf, y1);
                        }
                    }
                }
                const float ecs = __expf(db[tok]);
                float ssq = 0.f;
                if (valid && !dry) {
#pragma unroll
                    for (int q = 0; q < 4; ++q) {
                        const float z0 = bflo(zn[q].x), z1 = bfhi(zn[q].x), z2 = bflo(zn[q].y), z3 = bfhi(zn[q].y);
                        const float o0 = (y1[4 * q] + ecs * y2[4 * q]) * silu_f(z0), o1 = (y1[4 * q + 1] + ecs * y2[4 * q + 1]) * silu_f(z1);
                        const float o2 = (y1[4 * q + 2] + ecs * y2[4 * q + 2]) * silu_f(z2), o3 = (y1[4 * q + 3] + ecs * y2[4 * q + 3]) * silu_f(z3);
                        v2u w; w.x = pk2(o0, o1); w.y = pk2(o2, o3);
                        *(v2u*)(zrow + 8 * q) = w;
                        const float r0 = bflo(w.x), r1 = bfhi(w.x), r2 = bflo(w.y), r3 = bfhi(w.y);
                        ssq += (r0 * r0 + r1 * r1) + (r2 * r2 + r3 * r3);
                    }
                }
                ssq += shfl_from(ssq, lane ^ 32);
                if (valid && !dry && h == 0) atomicAdd(ssg + (size_t)g * MP + row0 + pos, (unsigned long long)(ssq * 1048576.0f + 0.5f));
                {
                    const int posn = min(64 * min(c + 1, nchunks - 1) + tok, L - 1);
                    const bf16* zr = Z + (size_t)(row0 + posn) * DI + hd * 64 + 32 * pbY + 4 * h;
#pragma unroll
                    for (int q = 0; q < 4; ++q) zn[q] = *(const v2u*)(zr + 8 * q);
                }
            }
            SCAN_BAR();
        }
        if (wave >= 4 && !dry) {
            const int nb = wq;
            float* so = sample ? P.out + O_SSSD + (((size_t)j2 * NS + b) * NH + hd) * (HD * NST) : P.out + O_PSSD + (((size_t)j2 * NB + b) * NH + hd) * (HD * NST);
#pragma unroll
            for (int pb = 0; pb < 2; ++pb)
#pragma unroll
                for (int q = 0; q < 4; ++q) { f32x4 v = {sacc[pb][4 * q], sacc[pb][4 * q + 1], sacc[pb][4 * q + 2], sacc[pb][4 * q + 3]};
                    *(f32x4*)(so + (size_t)(32 * pb + r) * NST + 32 * nb + 8 * q + 4 * h) = v; }
        }
    }
}

#ifndef WGM_STORE
#define WGM_STORE 6
#endif
#ifndef WGM_G1
#define WGM_G1 WGM_STORE
#endif
#ifndef WGM_G5
#define WGM_G5 WGM_STORE
#endif
#ifndef WGM_G3
#define WGM_G3 5
#endif
#ifndef WGM_RES
#define WGM_RES 2
#endif
__global__ void __launch_bounds__(NWAVES * 64, 2) hybrid_fwd(Params P) {
    extern __shared__ __attribute__((aligned(16))) unsigned char lds_raw[];
    Ctx F;
    F.lds = (LAS unsigned char*)lds_raw;
    F.tid = threadIdx.x; F.lane = F.tid & 63; F.wave = __builtin_amdgcn_readfirstlane(F.tid >> 6);
    F.G = gridDim.x; { const int bx = blockIdx.x; F.vcu = (F.G % 8 == 0) ? (bx % 8) * (F.G / 8) + bx / 8 : bx; }
    volatile LAS unsigned* MISC = (volatile LAS unsigned*)(F.lds + MISC_OFF);
    for (int u = F.tid; u < (LDS_BYTES - LDSCTL_OFF) / 4; u += NWAVES * 64) ((LAS unsigned*)(F.lds + LDSCTL_OFF))[u] = 0u;
    __syncthreads();
    XcdBarrier bar = xcd_barrier_post((unsigned*)(P.ws + WS_CTL) + CW_BAR, MISC + 8);

    bf16* const H = (bf16*)(P.ws + WS_H + H_PAD);
    unsigned char* const BIG = P.ws + WS_BIG;

    unsigned long long* const SS = (unsigned long long*)(P.ws + WS_SS);
    for (int rp = 0; rp < ((PROBE & 1) ? 2 : 1); ++rp) { embed_phase(F, P); if (PROBE & 1) xcd_barrier(bar); }
    convert_layer_weights(F, P, 0, 0);
    xcd_barrier(bar);
    for (int layer = 0; layer < 4; ++layer) {
        const int j = layer >> 1; const bool ssd = layer & 1;
        bf16* const WT = (bf16*)(P.ws + WS_WT + (size_t)(layer & 1) * WT_BUF_BYTES);
        if (!ssd) {
            pg8::Gemm g{H, WT + WT_IN, MP, 3 * D, D};
            pg8::RowOrder S; S.init(0, MP / 256, g.N / 256, F.G, opaque_s((int)blockIdx.x)); S.wgm = WGM_G1; S.rev = 1;
            pg8::EpiStore E; E.O1 = (bf16*)(BIG + BIG_BG); E.ld1 = D; E.n1 = 8; E.O2 = (bf16*)(BIG + BIG_CV); E.ld2 = D; E.n2 = 24; E.F3 = nullptr; E.ld3 = 0; E.ncv0 = 8;
            E.ss = SS + (size_t)(2 * layer) * MP;
            constexpr int NR = 1 + ((PROBE & 4) ? 1 : 0) + ((PROBE & 16) ? 1 : 0);
            for (int rp = 0; rp < NR; ++rp) { E.dry = ((PROBE & 16) && rp == 0) ? 1 : 0; pg8::gemm_phase<pg8::EpiStore, pg8::RowOrder, true, true>(F.lds + RING_OFF, g, S, E); xcd_barrier(bar); }
        } else {
            pg8::Gemm g{H, WT + WT_IN, MP, NINP, D};
            pg8::RowOrder S; S.init(0, SSD_ROW_TILES, NINP / 256, F.G, opaque_s((int)blockIdx.x)); S.wgm = WGM_G5;
            const int Gs = opaque_s(F.G), rem = S.nwg % Gs; S.lim = S.nwg - rem;
            pg8::RowOrderSK SK{S, S.lim, rem ? min(pg8::SK_MAXPARTS, Gs / rem) : 1, g.K / pg8::BK};
            pg8::EpiSsdIn<false> E{(bf16*)(BIG + BIG_Z), (bf16*)(BIG + BIG_XBC), (float*)(BIG + BIG_DT), SS + (size_t)(2 * layer) * MP,
                            P.in[I_SSD_CW] + (size_t)j * 4 * CONVD, P.in[I_SSD_CB] + (size_t)j * CONVD, P.in[I_SSD_DTB] + (size_t)j * NH, (float*)(BIG + BIG_RAWB),
                            P.out + O_PSSDCONV + (size_t)j * NB * 3 * CONVD, P.out + O_SSSDCONV + (size_t)j * NS * 3 * CONVD, 0, F.lds + EPI_WL_OFF, nullptr, nullptr};
            pg8::EpiSsdIn<true> EK{E.Z, E.XBC, E.DTo, E.ss, E.cw, E.cb, E.dtb, E.rawb, E.outp, E.outs, 0, E.wl,
                            (float*)(P.ws + WS_WT + (size_t)((layer + 1) & 1) * WT_BUF_BYTES), (unsigned*)(P.ws + WS_CTL + CTL_SKF) + (size_t)(5 + j) * SKF_WORDS};
            {
                unsigned long long* ssg = (unsigned long long*)(P.ws + WS_WT + (size_t)((layer + 1) & 1) * WT_BUF_BYTES + SSG_OFF);
                const unsigned zu = __builtin_bit_cast(unsigned, opaque_zero()); const unsigned long long z8 = ((unsigned long long)zu << 32) | zu;
                for (int i = (int)blockIdx.x * (NWAVES * 64) + opaque_i((int)threadIdx.x); i < 8 * MP; i += Gs * (NWAVES * 64)) ssg[i] = z8;
            }
            pg8::gemm_phase<pg8::EpiSsdIn<false>, pg8::RowOrder, true, true>(F.lds + RING_OFF, g, S, E);
            pg8::gemm_phase<pg8::EpiSsdIn<true>, pg8::RowOrderSK, true, true>(F.lds + RING_OFF, g, SK, EK);
            xcd_barrier(bar);
        }
        if (!ssd) { for (int rp = 0; rp < ((PROBE & 1) ? 2 : 1); ++rp) { sc_gate_phase(F, P, j); xcd_barrier(bar); } }
        else { ssd_scan_phase(F, P, j, false, (unsigned long long*)(P.ws + WS_WT + (size_t)((layer + 1) & 1) * WT_BUF_BYTES + SSG_OFF)); xcd_barrier(bar); }
        {
            pg8::Gemm g{ssd ? (const bf16*)(BIG + BIG_Z) : (const bf16*)(BIG + BIG_G), WT + WT_OUT, MP, D, ssd ? DI : D};
            pg8::RowOrder S; S.init(0, MP / 256, D / 256, F.G, opaque_s((int)blockIdx.x)); S.wgm = WGM_RES;
            const int Gs = opaque_s(F.G), rem = S.nwg % Gs; S.lim = S.nwg - rem;
            pg8::RowOrderSK SK{S, S.lim, rem ? min(pg8::SK_MAXPARTS, Gs / rem) : 1, g.K / pg8::BK};
            float* const skp = (float*)(BIG + BIG_SKP); unsigned* const skf = (unsigned*)(P.ws + WS_CTL + CTL_SKF) + (size_t)layer * SKF_WORDS;
            if (!ssd) {
                pg8::EpiRes<false> E{H, SS + (size_t)(2 * layer + 1) * MP, D, 0, nullptr, nullptr, nullptr, 0};
                pg8::EpiRes<true> EK{H, SS + (size_t)(2 * layer + 1) * MP, D, 0, skp, skf, nullptr, 0};
                pg8::gemm_phase<pg8::EpiRes<false>, pg8::RowOrder, true, true>(F.lds + RING_OFF, g, S, E);
                pg8::gemm_phase<pg8::EpiRes<true>, pg8::RowOrderSK, true, true>(F.lds + RING_OFF, g, SK, EK);
            } else {
                const unsigned long long* ssg = (const unsigned long long*)(P.ws + WS_WT + (size_t)((layer + 1) & 1) * WT_BUF_BYTES + SSG_OFF);
                pg8::EpiRes<false, true> E{H, SS + (size_t)(2 * layer + 1) * MP, D, 0, nullptr, nullptr, ssg, MP};
                pg8::EpiRes<true, true> EK{H, SS + (size_t)(2 * layer + 1) * MP, D, 0, skp, skf, ssg, MP};
                pg8::gemm_phase<pg8::EpiRes<false, true>, pg8::RowOrder, true, true>(F.lds + RING_OFF, g, S, E);
                pg8::gemm_phase<pg8::EpiRes<true, true>, pg8::RowOrderSK, true, true>(F.lds + RING_OFF, g, SK, EK);
            }
            xcd_barrier(bar);
        }
        {
            pg8::Gemm g{H, WT + WT_UP, MP, NUP, D};
            pg8::RowOrder S; S.init(0, FFN_ROW_TILES, NUP / 256, F.G, opaque_s((int)blockIdx.x)); S.wgm = WGM_G3; S.rev = 1;
            pg8::EpiFfn E{(bf16*)(BIG + BIG_ACT), P.in[I_FFN_CW] + (size_t)layer * 3 * NUP, P.in[I_FFN_CB] + (size_t)layer * NUP, P.in[I_ST_FFN] + (size_t)layer * NS * 2 * NUP,
                          P.out + O_PFFN + (size_t)layer * NB * 2 * NUP, P.out + O_SFFN + (size_t)layer * NS * 2 * NUP, SS + (size_t)(2 * layer + 1) * MP, 0, F.lds + EPI_WL_OFF};
            constexpr int NR = 1 + ((PROBE & (4 | 64)) ? 1 : 0) + ((PROBE & (16 | 128)) ? 1 : 0);
            for (int rp = 0; rp < NR; ++rp) { E.dry = ((PROBE & (16 | 128)) && rp == 0) ? 1 : 0; pg8::gemm_phase<pg8::EpiFfn, pg8::RowOrder, true, true>(F.lds + RING_OFF, g, S, E); xcd_barrier(bar); }
        }
        {
            pg8::Gemm g{(const bf16*)(BIG + BIG_ACT), WT + WT_DOWN, MP, D, DFF};
            pg8::RowOrder S; S.init(0, MP / 256, D / 256, F.G, opaque_s((int)blockIdx.x)); S.wgm = WGM_RES;
            const int Gs = opaque_s(F.G), rem = S.nwg % Gs;
            if (layer == 3) S.lim = S.nwg - rem;
            pg8::RowOrderSK SK{S, S.lim, rem ? min(pg8::SK_MAXPARTS, Gs / rem) : 1, g.K / pg8::BK};
            pg8::EpiRes<false> E{H, SS + (size_t)(2 * layer + 2) * MP, D, 0, nullptr, nullptr, nullptr, 0};
            pg8::EpiRes<true> EK{H, SS + (size_t)(2 * layer + 2) * MP, D, 0, (float*)(BIG + BIG_SKP), (unsigned*)(P.ws + WS_CTL + CTL_SKF) + (size_t)4 * SKF_WORDS, nullptr, 0};
            pg8::gemm_phase<pg8::EpiRes<false>, pg8::RowOrder, true, true>(F.lds + RING_OFF, g, S, E);
            if (layer < 3) convert_layer_weights(F, P, layer + 1, rem);
            else pg8::gemm_phase<pg8::EpiRes<true>, pg8::RowOrderSK, true, true>(F.lds + RING_OFF, g, SK, EK);
            xcd_barrier(bar);
        }
    }
    for (int rp = 0; rp < ((PROBE & 1) ? 2 : 1); ++rp) final_norm_phase(F, P);
}

extern "C" void kernel_launch(void* const* d_in, const int* in_sizes, int n_in, void* d_out, int out_size, void* d_ws, size_t ws_size, hipStream_t stream) {
    static int grid = 0;
    if (grid == 0) {
        if (n_in != N_IN || in_sizes[I_XP] != NB * SEQ * D || (size_t)out_size != O_END || ws_size < WS_END) {
            fprintf(stderr, "kernel_launch: unexpected shapes (n_in %d, in0 %d, out %d, ws %zu, need %zu); nothing launched\n", n_in, n_in > 0 ? in_sizes[0] : -1, out_size, ws_size, (size_t)WS_END); grid = -1; return; }
        int dev = 0, cus = 0, per_cu = 0;
        if (hipGetDevice(&dev) != hipSuccess || hipDeviceGetAttribute(&cus, hipDeviceAttributeMultiprocessorCount, dev) != hipSuccess) { grid = -1; return; }
        if (hipFuncSetAttribute((const void*)hybrid_fwd, hipFuncAttributeMaxDynamicSharedMemorySize, LDS_BYTES) != hipSuccess) { fprintf(stderr, "kernel_launch: hipFuncSetAttribute failed\n"); grid = -1; return; }
        if (hipOccupancyMaxActiveBlocksPerMultiprocessor(&per_cu, (const void*)hybrid_fwd, NWAVES * 64, LDS_BYTES) != hipSuccess || per_cu < 1) {
            fprintf(stderr, "kernel_launch: occupancy query reports %d workgroups per CU; nothing launched\n", per_cu); (void)hipGetLastError(); grid = -1; return; }
        grid = cus;
    }
    if (grid < 0) return;
    if (hipMemsetAsync((char*)d_ws + WS_CTL, 0, CTL_ZERO_BYTES, stream) != hipSuccess) return;
    Params p{};
    for (int i = 0; i < N_IN; ++i) p.in[i] = (const float*)d_in[i];
    p.out = (float*)d_out; p.ws = (unsigned char*)d_ws;
    hipLaunchKernelGGL(hybrid_fwd, dim3(grid), dim3(NWAVES * 64), LDS_BYTES, stream, p);
}
```

```cpp
#include <hip/hip_runtime.h>
#include <cstdio>
#include <cstdint>
#ifndef PROBE
#define PROBE 0
#endif

constexpr int D = 2048, NB = 4, SEQ = 8192, NMETA = 16, LP = SEQ + NMETA;
constexpr int NS = 32, LS = 64;
constexpr int TP = NB * LP, TS = NS * LS, T = TP + TS;
constexpr int MP = 35072;
constexpr int DFF = 5632, NUP = 2 * DFF;
constexpr int DI = 4096, NH = 64, HD = 64, NG = 8, NST = 128, CONVD = 6144;
constexpr int NIN = 2 * DI + 2 * NG * NST + NH, NINP = 10496;
constexpr float EPS = 1e-6f;
static_assert(MP % 256 == 0 && MP >= T && NINP % 256 == 0 && NINP >= NIN && NIN == 10304 && T == 34880, "shapes");

enum { I_XP = 0, I_XS, I_ST_CONVA, I_ST_SSDCONV, I_ST_SSD, I_ST_FFN, I_META, I_NMIX, I_NFFN, I_NFINAL, I_SC_WIN, I_SC_CW, I_SC_WOUT,
       I_SSD_WIN, I_SSD_CW, I_SSD_CB, I_SSD_DTB, I_SSD_ALOG, I_SSD_D, I_SSD_NW, I_SSD_WOUT, I_FFN_WUP, I_FFN_CW, I_FFN_CB, I_FFN_WDOWN, N_IN };
constexpr size_t O_YP = 0, O_YS = 67108864, O_PCONVA = 71303168, O_PSSDCONV = 71335936, O_PSSD = 71483392, O_PFFN = 75677696,
                 O_SCONVA = 76038144, O_SSSDCONV = 76300288, O_SSSD = 77479936, O_SFFN = 111034368, O_END = 113917952;

#define GAS __attribute__((address_space(1)))
#define LAS __attribute__((address_space(3)))
typedef unsigned short bf16;
typedef unsigned v4u __attribute__((ext_vector_type(4)));
typedef unsigned v2u __attribute__((ext_vector_type(2)));
typedef float f32x4 __attribute__((ext_vector_type(4)));
typedef float f32x2 __attribute__((ext_vector_type(2)));
typedef float f32x16 __attribute__((ext_vector_type(16)));
typedef short bf16x8 __attribute__((ext_vector_type(8)));
typedef __bf16 bf2_t __attribute__((ext_vector_type(2)));

__device__ __forceinline__ unsigned pk2(float lo, float hi) { f32x2 v = {lo, hi}; bf2_t r = __builtin_convertvector(v, bf2_t); return __builtin_bit_cast(unsigned, r); }
__device__ __forceinline__ int opaque_i(int x) { asm volatile("" : "+v"(x)); return x; }
__device__ __forceinline__ int opaque_s(int x) { asm volatile("" : "+s"(x)); return x; }
__device__ __forceinline__ float shfl_from(float v, int srclane) { return __builtin_bit_cast(float, __builtin_amdgcn_ds_bpermute(srclane << 2, __builtin_bit_cast(int, v))); }
__device__ __forceinline__ float opaque_zero() { float z = 0.f; asm volatile("" : "+v"(z)); return z; }
__device__ __forceinline__ float ss_to_rstd(unsigned long long q) { return __builtin_amdgcn_rsqf((float)q * (1.0f / 1048576.0f / D) + EPS); }
__device__ __forceinline__ float bflo(unsigned u) { return __builtin_bit_cast(float, u << 16); }
__device__ __forceinline__ float bfhi(unsigned u) { return __builtin_bit_cast(float, u & 0xffff0000u); }
__device__ __forceinline__ float fast_rcp(float x) { return __builtin_amdgcn_rcpf(x); }
__device__ __forceinline__ float softplus_f(float v) { return (v > 20.f) ? v : __logf(1.0f + __expf(v)); }
__device__ __forceinline__ float silu_f(float x) { return x * fast_rcp(1.0f + __expf(-x)); }

namespace pg8 {
#define PG8_LAS __attribute__((address_space(3)))
typedef unsigned short bf16_t;
typedef short bf16x8 __attribute__((ext_vector_type(8)));
typedef float f32x4 __attribute__((ext_vector_type(4)));
typedef unsigned u32x4 __attribute__((ext_vector_type(4)));
constexpr int BM = 256, BK = 64, HALF = 128, HTB = HALF * BK * 2  , STAGE_BYTES = 8 * HTB, NXCD = 8, WGM = 4;

__host__ __device__ __forceinline__ int lds_byte(int r, int c) { const int st = (r >> 4) * 2 + (c >> 5), rr = r & 15, cc = c & 31, ob = rr * 64 + cc * 2; return st * 1024 + (ob ^ (((ob >> 9) & 1) << 5)); }
__host__ __device__ __forceinline__ void stage_rc(int b, int& R, int& C) { const int st = b / 1024, sb = b % 1024, swz = sb ^ (((sb >> 9) & 1) << 5); R = (st >> 1) * 16 + swz / 64; C = (st & 1) * 32 + (swz % 64) / 2; }
__host__ __device__ __forceinline__ int perm32(int rho) { const int n = rho >> 4, i = rho & 15; return 8 * (i >> 2) + 4 * n + (i & 3); }

struct Unit { int pm, pn; int kt0, ktn, part, nparts, slot; };
struct Gemm { const bf16_t* A; const bf16_t* Bt; int M, N, K; };

struct RowOrder {
    int nM, nN, nwg, G, c, pm0, wgm, lim, rev;
    __device__ void init(int pm0_, int nM_, int nN_, int G_, int c_) { pm0 = pm0_; nM = nM_; nN = nN_; nwg = nM * nN; G = G_; c = c_; wgm = WGM; lim = nwg; rev = 0; }
    __device__ void unit_of(int wgid, Unit& u) const {
        { const int q = nwg / NXCD, r = nwg % NXCD, xcd = wgid % NXCD, off = wgid / NXCD; wgid = (xcd < r ? xcd * (q + 1) : r * (q + 1) + (xcd - r) * q) + off; }
        const int nig = wgm * nN, gid = wgid / nig, fm = gid * wgm, gsz = (nM - fm) < wgm ? (nM - fm) : wgm;
        u.pm = pm0 + fm + ((wgid % nig) % gsz); u.pn = (wgid % nig) / gsz;
        if (rev) u.pm = pm0 + (nM - 1) - (u.pm - pm0);
    }
    __device__ bool next(int i, Unit& u) const {
        const long L = (long)i * G + c; if (L >= lim) return false;
        unit_of((int)L, u); return true;
    }
    __device__ __forceinline__ void a_ready(const Unit&) const {}
    __device__ __forceinline__ void done(const Unit&) const {}
};
struct RowOrderSK {
    RowOrder R; int first, ns, nt;
    __device__ bool next(int i, Unit& u) const {
        const long Lh = (long)i * R.G + R.c; const int xcd = (int)(Lh % NXCD), offh = (int)(Lh / NXCD);
        const int part = offh % ns; const long L = (long)first + (long)NXCD * (offh / ns) + xcd; if (L >= R.nwg) return false;
        R.unit_of((int)L, u); u.part = part; u.nparts = ns; u.slot = (int)L - first;
        const int pairs = nt >> 1; u.kt0 = 2 * ((part * pairs) / ns); u.ktn = 2 * (((part + 1) * pairs) / ns) - u.kt0; return true;
    }
    __device__ __forceinline__ void a_ready(const Unit&) const {}
    __device__ __forceinline__ void done(const Unit&) const {}
};


struct EpiStore {
    static constexpr bool PERM = true, AFTER_DRAIN = false, SPLITK = false, KGROUP = false, HEADPF = false; static constexpr int AMAP = 0;
    static __device__ __forceinline__ int a_row0(int pm) { return BM * pm; }
    bf16_t* O1; int ld1; int n1; bf16_t* O2; int ld2; int n2; float* F3; int ld3; const unsigned long long* ss; int dry; int ncv0;
    __device__ __forceinline__ void operator()(const f32x4 (&acc)[2][2][4][2], const Unit& u, int wr, int wc, int fr, int fq) const {
        if (dry) return;
        const int row0 = u.pm * BM + wr * 64 + fr;
        float rs[2][4];
#pragma unroll
        for (int ai = 0; ai < 2; ++ai)
#pragma unroll
            for (int m = 0; m < 4; ++m) rs[ai][m] = 0.f;
        {
            unsigned long long q[8];
#pragma unroll
            for (int i = 0; i < 8; ++i) q[i] = ss[row0 + (i >> 2) * HALF + (i & 3) * 16];
            asm volatile("" ::: "memory");
#pragma unroll
            for (int i = 0; i < 8; ++i) rs[i >> 2][i & 3] = ss_to_rstd(q[i]);
        }
        if (u.pn >= ncv0) {
            const int ch0 = 128 * (u.pn - ncv0) + wc * 32 + 8 * fq;
#pragma unroll
            for (int ai = 0; ai < 2; ++ai)
#pragma unroll
                for (int m = 0; m < 4; ++m) { const float r2 = rs[ai][m] * rs[ai][m];
                    const f32x4 p0 = acc[ai][0][m][0] * acc[ai][1][m][0] * r2, p1 = acc[ai][0][m][1] * acc[ai][1][m][1] * r2;
                    u32x4 w; w.x = pk2(p0[0], p0[1]); w.y = pk2(p0[2], p0[3]); w.z = pk2(p1[0], p1[1]); w.w = pk2(p1[2], p1[3]);
                    *(u32x4*)(O2 + (size_t)(row0 + ai * HALF + m * 16) * ld2 + ch0) = w; }
        } else if (u.pn < n2) {
            bf16_t* base; int ld, colt;
            if (u.pn < n1) { base = O1; ld = ld1; colt = u.pn * BM; } else { base = O2; ld = ld2; colt = (u.pn - n1) * BM; }
            const int col0 = colt + wc * 32 + 8 * fq;
#pragma unroll
            for (int ai = 0; ai < 2; ++ai)
#pragma unroll
                for (int m = 0; m < 4; ++m) { bf16_t* rowp = base + (size_t)(row0 + ai * HALF + m * 16) * ld + col0;
#pragma unroll
                    for (int bj = 0; bj < 2; ++bj) { const f32x4 v0 = acc[ai][bj][m][0] * rs[ai][m], v1 = acc[ai][bj][m][1] * rs[ai][m];
                        u32x4 w; w.x = pk2(v0[0], v0[1]); w.y = pk2(v0[2], v0[3]); w.z = pk2(v1[0], v1[1]); w.w = pk2(v1[2], v1[3]);
                        *(u32x4*)(rowp + bj * HALF) = w; } }
        } else {
            const int col0 = wc * 32 + 8 * fq;
            if (col0 < ld3) {
#pragma unroll
                for (int ai = 0; ai < 2; ++ai)
#pragma unroll
                    for (int m = 0; m < 4; ++m) { float* rowp = F3 + (size_t)(row0 + ai * HALF + m * 16) * ld3 + col0;
                        *(f32x4*)(rowp) = acc[ai][0][m][0] * rs[ai][m]; *(f32x4*)(rowp + 4) = acc[ai][0][m][1] * rs[ai][m]; }
            }
        }
    }
};
constexpr int SK_MAXPARTS = 3;
constexpr size_t SK_PART_FLOATS = (size_t)BM * BM;
__device__ __forceinline__ bool sk_exchange(f32x4 (&acc)[2][2][4][2], const Unit& u, float* pbuf, unsigned* flags) {
    const int tid = opaque_i((int)threadIdx.x);
    unsigned* flag = flags + (size_t)u.slot * 64;
    if (u.part != 0) {
        float* dst = pbuf + ((size_t)u.slot * (SK_MAXPARTS - 1) + (u.part - 1)) * SK_PART_FLOATS + (size_t)tid * 4;
#pragma unroll
        for (int q = 0; q < 32; ++q) { const f32x4 v = acc[q >> 4][(q >> 3) & 1][(q >> 1) & 3][q & 1]; float* d = dst + (size_t)q * 2048;
            asm volatile("global_store_dwordx4 %0, %1, off sc1" :: "v"(d), "v"(v) : "memory"); }
        asm volatile("s_waitcnt vmcnt(0)" ::: "memory");
        __builtin_amdgcn_s_barrier();
        if (tid == 0) (void)__hip_atomic_fetch_add(flag, 1u, __ATOMIC_RELAXED, __HIP_MEMORY_SCOPE_AGENT);
        return false;
    }
    const int np = u.nparts;
    if (np > 1) {
        if (tid < 64) {
            unsigned sp = 0;
            while ((unsigned)__builtin_amdgcn_readfirstlane(__hip_atomic_load(flag, __ATOMIC_RELAXED, __HIP_MEMORY_SCOPE_AGENT)) != (unsigned)(np - 1)) { __builtin_amdgcn_s_sleep(1); if (++sp > (1u << 22)) break; }
            __builtin_amdgcn_fence(__ATOMIC_ACQUIRE, "agent");
            asm volatile("s_waitcnt vmcnt(0)" ::: "memory");
        }
        __builtin_amdgcn_s_barrier();
        asm volatile("" ::: "memory");
        for (int p = 1; p < np; ++p) {
            const float* src = pbuf + ((size_t)u.slot * (SK_MAXPARTS - 1) + (p - 1)) * SK_PART_FLOATS + (size_t)tid * 4;
#pragma unroll
            for (int ai = 0; ai < 2; ++ai) {
                f32x4 t[16];
#pragma unroll
                for (int i = 0; i < 16; ++i) t[i] = *(const f32x4*)(src + (size_t)(ai * 16 + i) * 2048);
                asm volatile("" ::: "memory");
#pragma unroll
                for (int i = 0; i < 16; ++i) acc[ai][i >> 3][(i >> 1) & 3][i & 1] += t[i];
            }
        }
    }
    return true;
}
constexpr int KG_TAB_OFF = 131072, KG_TAB_BYTES = 8192;
template <bool SK = false, bool KG = false> struct EpiRes {
    static constexpr bool PERM = true, AFTER_DRAIN = false, SPLITK = SK, KGROUP = KG, HEADPF = false; static constexpr int AMAP = 0;
    static __device__ __forceinline__ int a_row0(int pm) { return BM * pm; }
    bf16_t* XB; unsigned long long* ss; int ldc; int dry;
    float* pbuf; unsigned* flags;
    const unsigned long long* ssg; int ssg_ld;
    __device__ __forceinline__ void kg_build(PG8_LAS float* tab, const Unit& u) const {
        const int t = opaque_i((int)threadIdx.x), lr = t >> 1, g0 = 4 * (t & 1);
        const unsigned long long* p = ssg + (size_t)g0 * ssg_ld + (size_t)u.pm * BM + lr;
        unsigned long long q[4];
#pragma unroll
        for (int i = 0; i < 4; ++i) q[i] = p[(size_t)i * ssg_ld];
        asm volatile("" ::: "memory");
        f32x4 sv;
#pragma unroll
        for (int i = 0; i < 4; ++i) sv[i] = __builtin_amdgcn_rsqf((float)q[i] * (1.0f / 1048576.0f / 512.0f) + 1e-6f);
        *(PG8_LAS f32x4*)(tab + lr * 8 + g0) = sv;
    }
    __device__ __forceinline__ void kg_rescale(f32x4 (&acc)[2][2][4][2], const PG8_LAS float* tab, int g, int wr, int fr) const {
#pragma unroll
        for (int ai = 0; ai < 2; ++ai)
#pragma unroll
            for (int m = 0; m < 4; ++m) { const PG8_LAS float* e = tab + (128 * ai + 64 * wr + 16 * m + fr) * 8 + g; const float ra = e[-1] * __builtin_amdgcn_rcpf(e[0]);
#pragma unroll
                for (int bj = 0; bj < 2; ++bj)
#pragma unroll
                    for (int n = 0; n < 2; ++n) acc[ai][bj][m][n] = acc[ai][bj][m][n] * ra; }
    }
    __device__ __forceinline__ void kg_finish(f32x4 (&acc)[2][2][4][2], const PG8_LAS float* tab, int g, int wr, int fr) const {
#pragma unroll
        for (int ai = 0; ai < 2; ++ai)
#pragma unroll
            for (int m = 0; m < 4; ++m) { const float ra = tab[(128 * ai + 64 * wr + 16 * m + fr) * 8 + g];
#pragma unroll
                for (int bj = 0; bj < 2; ++bj)
#pragma unroll
                    for (int n = 0; n < 2; ++n) acc[ai][bj][m][n] = acc[ai][bj][m][n] * ra; }
    }
    __device__ __forceinline__ bool part_exchange(f32x4 (&acc)[2][2][4][2], const Unit& u) const { return sk_exchange(acc, u, pbuf, flags); }
    __device__ __forceinline__ void operator()(const f32x4 (&acc)[2][2][4][2], const Unit& u, int wr, int wc, int fr, int fq) const {
        if (dry == 1) return;
        const float sc = dry ? 0.5f : 1.0f;
        const int row0 = u.pm * BM + wr * 64 + fr, col0 = u.pn * BM + wc * 32 + 8 * fq;
        u32x4 xin[2][4][2];
#pragma unroll
        for (int ai = 0; ai < 2; ++ai)
#pragma unroll
            for (int m = 0; m < 4; ++m)
#pragma unroll
                for (int bj = 0; bj < 2; ++bj) xin[ai][m][bj] = *(const u32x4*)(XB + (size_t)(row0 + ai * HALF + m * 16) * ldc + col0 + bj * HALF);
        float ssq[8];
#pragma unroll
        for (int ai = 0; ai < 2; ++ai)
#pragma unroll
            for (int m = 0; m < 4; ++m) { const int row = row0 + ai * HALF + m * 16; bf16_t* rowb = XB + (size_t)row * ldc + col0;
                float s = 0.f;
#pragma unroll
                for (int bj = 0; bj < 2; ++bj) {
                    const u32x4 q = xin[ai][m][bj]; const f32x4 a0 = acc[ai][bj][m][0] * sc, a1 = acc[ai][bj][m][1] * sc;
                    u32x4 w; w.x = pk2(bflo(q.x) + a0[0], bfhi(q.x) + a0[1]); w.y = pk2(bflo(q.y) + a0[2], bfhi(q.y) + a0[3]); w.z = pk2(bflo(q.z) + a1[0], bfhi(q.z) + a1[1]); w.w = pk2(bflo(q.w) + a1[2], bfhi(q.w) + a1[3]);
                    *(u32x4*)(rowb + bj * HALF) = w;
                    const float r0 = bflo(w.x), r1 = bfhi(w.x), r2 = bflo(w.y), r3 = bfhi(w.y), r4 = bflo(w.z), r5 = bfhi(w.z), r6 = bflo(w.w), r7 = bfhi(w.w);
                    s += ((r0 * r0 + r1 * r1) + (r2 * r2 + r3 * r3)) + ((r4 * r4 + r5 * r5) + (r6 * r6 + r7 * r7));
                }
                ssq[ai * 4 + m] = s;
            }
        {
            const int ln = opaque_i((int)threadIdx.x) & 63;
            float t[8];
#pragma unroll
            for (int i = 0; i < 8; ++i) t[i] = shfl_from(ssq[i], ln ^ 16);
#pragma unroll
            for (int i = 0; i < 8; ++i) ssq[i] += t[i];
#pragma unroll
            for (int i = 0; i < 8; ++i) t[i] = shfl_from(ssq[i], ln ^ 32);
#pragma unroll
            for (int i = 0; i < 8; ++i) ssq[i] += t[i];
        }
        if (fq == 0 && dry != 2) {
#pragma unroll
            for (int i = 0; i < 8; ++i) atomicAdd(ss + row0 + (i >> 2) * HALF + (i & 3) * 16, (unsigned long long)(ssq[i] * 1048576.0f + 0.5f));
        }
    }
};


__device__ __forceinline__ f32x2 silu2(f32x2 x) {
    f32x2 t = x * (-1.44269504f); t.x = __builtin_amdgcn_exp2f(t.x); t.y = __builtin_amdgcn_exp2f(t.y); t = t + 1.0f;
    f32x2 r; r.x = __builtin_amdgcn_rcpf(t.x); r.y = __builtin_amdgcn_rcpf(t.y); return x * r; }
__device__ __forceinline__ float dpp_shr1(float x) { return __builtin_bit_cast(float, __builtin_amdgcn_update_dpp(0, __builtin_bit_cast(int, x), 0x111, 0xf, 0xf, true)); }
__device__ __forceinline__ f32x2 dpp_shr1_2(f32x2 x) { f32x2 r; r.x = dpp_shr1(x.x); r.y = dpp_shr1(x.y); return r; }
struct EpiFfn {
    static constexpr bool PERM = true, AFTER_DRAIN = false, SPLITK = false, KGROUP = false, HEADPF = true; static constexpr int AMAP = 2;
    __device__ __forceinline__ void head_dma(const Unit& u, int b) const {
        const int tid2 = opaque_i((int)threadIdx.x), wid2 = __builtin_amdgcn_readfirstlane(tid2 >> 6), wr = wid2 >> 2, wc = wid2 & 3, ln = tid2 & 63;
        const int upm = opaque_s(u.pm), upn = opaque_s(u.pn);
        const int cc = ln & 31, hv = ln >> 5, wcol = (hv ? DFF : 0) + 128 * upn + 32 * wc + cc;
        PG8_LAS unsigned* wlw = (PG8_LAS unsigned*)(wl + b * 12288 + 1536 * (wr * 4 + wc));
        __builtin_amdgcn_global_load_lds((const unsigned*)(cw + wcol), wlw, 4, 0, 0);
        __builtin_amdgcn_global_load_lds((const unsigned*)(cw + NUP + wcol), wlw + 64, 4, 0, 0);
        __builtin_amdgcn_global_load_lds((const unsigned*)(cw + 2 * NUP + wcol), wlw + 128, 4, 0, 0);
        __builtin_amdgcn_global_load_lds((const unsigned*)(cb + wcol), wlw + 192, 4, 0, 0);
        if (wc == 0) {
            const unsigned* sp = (const unsigned*)(ss + (252 * upm - 2 + 126 * wr)) + ln;
            PG8_LAS unsigned* sl = (PG8_LAS unsigned*)(wl + 24576 + b * 2048 + wr * 1024);
#pragma unroll
            for (int k = 0; k < 4; ++k) __builtin_amdgcn_global_load_lds(sp + 64 * k, sl + 64 * k, 4, 0, 0);
        }
    }
    static __device__ __forceinline__ int a_row0(int pm) { return 252 * pm - 2; }
    bf16_t* ACT; const float* cw; const float* cb; const float* st; float* outp; float* outs; const unsigned long long* ss; int dry; PG8_LAS unsigned char* wl;
    __device__ __forceinline__ void operator()(const f32x4 (&acc)[2][2][4][2], const Unit& u, int wr_, int wc_, int fr_, int fq_, int hb) const {
        if (dry) return;
        const int tid2 = opaque_i((int)threadIdx.x), wid2 = __builtin_amdgcn_readfirstlane(tid2 >> 6);
        const int upm = opaque_s(u.pm), upn = opaque_s(u.pn), wr = wid2 >> 2, wc = wid2 & 3, fr = tid2 & 15, fq = (tid2 >> 4) & 3; (void)wr_; (void)wc_; (void)fr_; (void)fq_;
        const int span0 = 252 * upm - 2 + 126 * wr, rowb = span0 + 8 * fr;
        const int colj = 128 * upn + 32 * wc + 8 * fq;
        bool slow; { const int b = span0 + 128, k = (span0 + (LP - 2)) / LP; slow = (b > TP - 2) || (LP * k - 2 < b); }
        const int ln = tid2 & 63;
        PG8_LAS float* wlw = (PG8_LAS float*)(wl + hb * 12288 + 1536 * (wr * 4 + wc));
        float rs[8];
        {
            const PG8_LAS unsigned long long* sq = (const PG8_LAS unsigned long long*)(wl + 24576 + hb * 2048 + wr * 1024) + 8 * fr;
#pragma unroll
            for (int i = 0; i < 8; ++i) rs[i] = ss_to_rstd(sq[i]);
            (void)ln; (void)rowb;
        }
        unsigned pkd[8][4];
#pragma unroll
        for (int cq = 0; cq < 2; ++cq) {
#pragma unroll
            for (int cp2 = 0; cp2 < 2; ++cp2) {
                const int cp = 2 * cq + cp2, ca0 = colj + 2 * cp, cv0 = DFF + colj + 2 * cp;
                const PG8_LAS float* wq = wlw + 8 * fq + 2 * cp;
                const f32x2 w0a = *(const PG8_LAS f32x2*)(wq), w1a = *(const PG8_LAS f32x2*)(wq + 64), w2a = *(const PG8_LAS f32x2*)(wq + 128), ba = *(const PG8_LAS f32x2*)(wq + 192);
                const f32x2 w0v = *(const PG8_LAS f32x2*)(wq + 32), w1v = *(const PG8_LAS f32x2*)(wq + 96), w2v = *(const PG8_LAS f32x2*)(wq + 160), bv = *(const PG8_LAS f32x2*)(wq + 224);
                f32x2 a[10], v[10];
#pragma unroll
                for (int i = 0; i < 8; ++i) { const f32x4 A4 = acc[i >> 2][0][i & 3][cq], V4 = acc[i >> 2][1][i & 3][cq];
                    a[i + 2] = (cp2 ? (f32x2){A4[2], A4[3]} : (f32x2){A4[0], A4[1]}) * rs[i]; v[i + 2] = (cp2 ? (f32x2){V4[2], V4[3]} : (f32x2){V4[0], V4[1]}) * rs[i]; }
                a[1] = dpp_shr1_2(a[9]); a[0] = dpp_shr1_2(a[8]); v[1] = dpp_shr1_2(v[9]); v[0] = dpp_shr1_2(v[8]);
                if (!slow) {
#pragma unroll
                    for (int i = 0; i < 8; ++i) {
                        const f32x2 sa = w0a * a[i] + (w1a * a[i + 1] + (w2a * a[i + 2] + ba)), sv = w0v * v[i] + (w1v * v[i + 1] + (w2v * v[i + 2] + bv));
                        const f32x2 o = silu2(sa) * sv; pkd[i][2 * cq + cp2] = pk2(o.x, o.y);
                    }
                } else {
#pragma unroll
                    for (int i = 0; i < 8; ++i) {
                        f32x2 p2a = a[i], p1a = a[i + 1], p2v = v[i], p1v = v[i + 1];
                        const int r = rowb + i;
                        if (r >= 0 && r < T) {
                            int seq, pos, L; bool sample;
                            if (r < TP) { sample = false; seq = r / LP; pos = r - seq * LP; L = LP; } else { const int q = r - TP; sample = true; seq = q >> 6; pos = q & 63; L = LS; }
                            if (pos < 2) {
                                f32x2 h1a = {0.f, 0.f}, h2a = {0.f, 0.f}, h1v = {0.f, 0.f}, h2v = {0.f, 0.f};
                                if (sample) { const float* s = st + (size_t)seq * 2 * NUP; h2a = *(const f32x2*)(s + ca0); h1a = *(const f32x2*)(s + NUP + ca0); h2v = *(const f32x2*)(s + cv0); h1v = *(const f32x2*)(s + NUP + cv0); }
                                if (pos == 0) { p1a = h1a; p2a = h2a; p1v = h1v; p2v = h2v; } else { p2a = h1a; p2v = h1v; }
                            }
                            if (pos >= L - 2 && !(fr == 0 && i < 2)) {
                                float* ob = (sample ? outs : outp) + ((size_t)seq * 2 + (pos - (L - 2))) * NUP;
                                *(f32x2*)(ob + ca0) = a[i + 2]; *(f32x2*)(ob + cv0) = v[i + 2];
                            }
                        }
                        const f32x2 sa = w0a * p2a + (w1a * p1a + (w2a * a[i + 2] + ba)), sv = w0v * p2v + (w1v * p1v + (w2v * v[i + 2] + bv));
                        const f32x2 o = silu2(sa) * sv; pkd[i][2 * cq + cp2] = pk2(o.x, o.y);
                    }
                }
            }
        }
#pragma unroll
        for (int i = 0; i < 8; ++i) {
            if (!(fr == 0 && i < 2)) { u32x4 w; w.x = pkd[i][0]; w.y = pkd[i][1]; w.z = pkd[i][2]; w.w = pkd[i][3]; *(u32x4*)((char*)ACT + (unsigned)((rowb + i) * DFF + colj) * 2u) = w; }
        }
    }
};

template <bool SK = false> struct EpiSsdIn {
    static constexpr bool PERM = true, AFTER_DRAIN = false, SPLITK = SK, KGROUP = false, HEADPF = true; static constexpr int AMAP = 3;
    __device__ __forceinline__ void head_dma(const Unit& u, int b) const {
        const int tid2 = opaque_i((int)threadIdx.x), wid2 = __builtin_amdgcn_readfirstlane(tid2 >> 6), wr = wid2 >> 2, wc = wid2 & 3, ln = tid2 & 63;
        const int upm = opaque_s(u.pm), upn = opaque_s(u.pn);
        if (upn >= 16 && upn < 40) {
            const int cc = ln & 31, hv = ln >> 5, wcol = 256 * (upn - 16) + 128 * hv + 32 * wc + cc;
            PG8_LAS unsigned* wlw = (PG8_LAS unsigned*)(wl + b * 12288 + 1536 * (wr * 4 + wc));
#pragma unroll
            for (int k = 0; k < 4; ++k) __builtin_amdgcn_global_load_lds((const unsigned*)(cw + k * CONVD + wcol), wlw + 64 * k, 4, 0, 0);
            __builtin_amdgcn_global_load_lds((const unsigned*)(cb + wcol), wlw + 256, 4, 0, 0);
        }
        if (wc == 0) {
            const unsigned* sp = (const unsigned*)(ss + (250 * upm - 3 + 125 * wr)) + ln;
            PG8_LAS unsigned* sl = (PG8_LAS unsigned*)(wl + 24576 + b * 2048 + wr * 1024);
#pragma unroll
            for (int k = 0; k < 4; ++k) __builtin_amdgcn_global_load_lds(sp + 64 * k, sl + 64 * k, 4, 0, 0);
        }
    }
    static __device__ __forceinline__ int a_row0(int pm) { return 250 * pm - 3; }
    bf16_t* Z; bf16_t* XBC; float* DTo; const unsigned long long* ss; const float* cw; const float* cb; const float* dtb; float* rawb; float* outp; float* outs; int dry; PG8_LAS unsigned char* wl;
    float* pbuf; unsigned* flags;
    __device__ __forceinline__ bool part_exchange(f32x4 (&acc)[2][2][4][2], const Unit& u) const { return sk_exchange(acc, u, pbuf, flags); }
    __device__ __forceinline__ void operator()(const f32x4 (&acc)[2][2][4][2], const Unit& u, int wr_, int wc_, int fr_, int fq_, int hb) const {
        if (dry) return;
        const int tid2 = opaque_i((int)threadIdx.x), wid2 = __builtin_amdgcn_readfirstlane(tid2 >> 6);
        const int upm = opaque_s(u.pm), upn = opaque_s(u.pn), wr = wid2 >> 2, wc = wid2 & 3, fr = tid2 & 15, fq = (tid2 >> 4) & 3; (void)wr_; (void)wc_; (void)fr_; (void)fq_;
        const int span0 = 250 * upm - 3 + 125 * wr, rowb = span0 + 8 * fr;
        float rs[8];
        PG8_LAS float* wlw = (PG8_LAS float*)(wl + hb * 12288 + 1536 * (wr * 4 + wc));
        {
            const PG8_LAS unsigned long long* sq = (const PG8_LAS unsigned long long*)(wl + 24576 + hb * 2048 + wr * 1024) + 8 * fr;
#pragma unroll
            for (int i = 0; i < 8; ++i) rs[i] = ss_to_rstd(sq[i]);
        }
        if (upn < 16) {
            const int col0 = 256 * upn + 32 * wc + 8 * fq;
#pragma unroll
            for (int i = 0; i < 8; ++i) {
                if (!(fr == 0 && i < 3)) {
#pragma unroll
                    for (int bj = 0; bj < 2; ++bj) { const f32x4 v0 = acc[i >> 2][bj][i & 3][0] * rs[i], v1 = acc[i >> 2][bj][i & 3][1] * rs[i];
                        u32x4 w; w.x = pk2(v0[0], v0[1]); w.y = pk2(v0[2], v0[3]); w.z = pk2(v1[0], v1[1]); w.w = pk2(v1[2], v1[3]);
                        *(u32x4*)((char*)Z + (unsigned)((rowb + i) * DI + col0 + bj * HALF) * 2u) = w; }
                }
            }
        } else if (upn < 40) {
            const int colx0 = 256 * (upn - 16) + 32 * wc + 8 * fq;
            bool slow; { const int b = span0 + 128, k = (span0 + (LP - 3)) / LP; slow = (b > TP - 3) || (LP * k - 3 < b); }
            if (slow) {
#pragma unroll
                for (int i = 0; i < 8; ++i) {
                    const int r = rowb + i;
                    if (r >= 0 && r < T && !(fr == 0 && i < 3)) {
                        int seq, pos, L, sid; bool sample;
                        if (r < TP) { sample = false; seq = r / LP; pos = r - seq * LP; L = LP; sid = seq; } else { const int q = r - TP; sample = true; seq = q >> 6; pos = q & 63; L = LS; sid = NB + seq; }
                        float* ob = nullptr;
                        if (pos < 3) ob = rawb + (size_t)(sid * 3 + pos) * CONVD; else if (pos >= L - 3) ob = (sample ? outs : outp) + (size_t)(seq * 3 + (pos - (L - 3))) * CONVD;
                        if (ob) {
#pragma unroll
                            for (int bj = 0; bj < 2; ++bj)
#pragma unroll
                                for (int n = 0; n < 2; ++n) *(f32x4*)(ob + colx0 + 128 * bj + 4 * n) = acc[i >> 2][bj][i & 3][n] * rs[i];
                        }
                    }
                }
            }
#pragma unroll
            for (int bj = 0; bj < 2; ++bj) {
#pragma unroll
                for (int cq = 0; cq < 2; ++cq) {
                    const int colx = colx0 + 128 * bj + 4 * cq;
                    unsigned pkd[8][2];
#pragma unroll
                    for (int cp2 = 0; cp2 < 2; ++cp2) {
                        const PG8_LAS float* wq = wlw + 32 * bj + 8 * fq + 4 * cq + 2 * cp2;
                        const f32x2 w0 = *(const PG8_LAS f32x2*)(wq), w1 = *(const PG8_LAS f32x2*)(wq + 64), w2 = *(const PG8_LAS f32x2*)(wq + 128), w3 = *(const PG8_LAS f32x2*)(wq + 192), bb = *(const PG8_LAS f32x2*)(wq + 256);
                        f32x2 uu[11];
#pragma unroll
                        for (int i = 0; i < 8; ++i) { const f32x4 A4 = acc[i >> 2][bj][i & 3][cq]; uu[i + 3] = (cp2 ? (f32x2){A4[2], A4[3]} : (f32x2){A4[0], A4[1]}) * rs[i]; }
                        uu[2] = dpp_shr1_2(uu[10]); uu[1] = dpp_shr1_2(uu[9]); uu[0] = dpp_shr1_2(uu[8]);
#pragma unroll
                        for (int i = 0; i < 8; ++i) { const f32x2 ov = silu2((w0 * uu[i] + w1 * uu[i + 1]) + (w2 * uu[i + 2] + (w3 * uu[i + 3] + bb))); pkd[i][cp2] = pk2(ov.x, ov.y); }
                    }
#pragma unroll
                    for (int i = 0; i < 8; ++i) {
                        if (!(fr == 0 && i < 3)) { v2u w; w.x = pkd[i][0]; w.y = pkd[i][1]; *(v2u*)((char*)XBC + (unsigned)((rowb + i) * CONVD + colx) * 2u) = w; }
                    }
                }
            }
        } else {
            const int col0 = 32 * wc + 8 * fq;
            if (col0 < NH) {
                const f32x4 b0 = *(const f32x4*)(dtb + col0), b1 = *(const f32x4*)(dtb + col0 + 4);
#pragma unroll
                for (int i = 0; i < 8; ++i) {
                    if (!(fr == 0 && i < 3)) {
                        f32x4 v0 = acc[i >> 2][0][i & 3][0] * rs[i] + b0, v1 = acc[i >> 2][0][i & 3][1] * rs[i] + b1;
#pragma unroll
                        for (int e = 0; e < 4; ++e) { v0[e] = softplus_f(v0[e]); v1[e] = softplus_f(v1[e]); }
                        char* rowp = (char*)DTo + (unsigned)((rowb + i) * NH + col0) * 4u;
                        *(f32x4*)rowp = v0; *(f32x4*)(rowp + 16) = v1;
                    }
                }
            }
        }
    }
};

template <class Epi, class Sched, bool ALIGN_EPI = false, bool SP2 = false>
__device__ __forceinline__ void gemm_phase(PG8_LAS unsigned char* lds, const Gemm g, const Sched& S, const Epi& E) {
    const int tid = opaque_i((int)threadIdx.x), wid = __builtin_amdgcn_readfirstlane(tid >> 6), lane = tid & 63, wr = wid >> 2, wc = wid & 3, fr = lane & 15, fq = lane >> 4;
    const int K = g.K, nt = K / BK;
    constexpr bool SK = Epi::SPLITK;
    constexpr bool KG = Epi::KGROUP;
    unsigned voffA[2], voffB[2];
#pragma unroll
    for (int i = 0; i < 2; ++i) { int R, C; stage_rc(tid * 16 + i * 8192, R, C); const int Rb = Epi::PERM ? ((R & ~31) + perm32(R & 31)) : R;
        const int Ra = Epi::AMAP ? ((128 - Epi::AMAP) * (R >> 6) + 8 * (R & 15) + ((R >> 4) & 3)) : R;
        voffA[i] = (unsigned)(Ra * K + C) * 2u; voffB[i] = (unsigned)(Rb * K + C) * 2u; }
    const size_t kstep = (size_t)(BK * 2);
    const size_t hstepB = (size_t)HALF * K * 2;
    const size_t hstepA = Epi::AMAP ? (size_t)4 * K * 2 : hstepB;
    const size_t tstepB = 2 * hstepB;
    const size_t rstepA = (size_t)K * 2;
    const unsigned ldsw = (unsigned)wid * 1024u;
    const int aoff = lds_byte(wr * 64 + fr, fq * 8), boff = lds_byte(wc * 32 + fr, fq * 8);
#define PG8_SA(b, h) (((b) * 2 + (h)) * HTB)
#define PG8_SB(b, h) ((4 + (b) * 2 + (h)) * HTB)
#define PG8_STAGE(bufoff, gbase, voff) do { _Pragma("unroll") for (int _i = 0; _i < 2; ++_i) \
        __builtin_amdgcn_global_load_lds((const unsigned*)((const char*)(gbase) + (voff)[_i]), (PG8_LAS unsigned*)(lds + (bufoff) + ldsw + _i * 8192), 16, 0, 0); } while (0)
#define PG8_LDA(dst, b, h) do { _Pragma("unroll") for (int m = 0; m < 4; ++m) _Pragma("unroll") for (int k = 0; k < 2; ++k) dst[m][k] = *(const PG8_LAS bf16x8*)(lds + PG8_SA(b, h) + aoff + m * 2048 + k * 1024); } while (0)
#define PG8_LDB(dst, b, h) do { _Pragma("unroll") for (int n = 0; n < 2; ++n) _Pragma("unroll") for (int k = 0; k < 2; ++k) dst[n][k] = *(const PG8_LAS bf16x8*)(lds + PG8_SB(b, h) + boff + n * 2048 + k * 1024); } while (0)
#define PG8_MMA(ai, bj, At, Bt) do { __builtin_amdgcn_s_setprio(1); _Pragma("unroll") for (int m = 0; m < 4; ++m) _Pragma("unroll") for (int n = 0; n < 2; ++n) _Pragma("unroll") for (int k = 0; k < 2; ++k) \
        acc[ai][bj][m][n] = __builtin_amdgcn_mfma_f32_16x16x32_bf16(Bt[n][k], At[m][k], acc[ai][bj][m][n], 0, 0, 0); __builtin_amdgcn_s_setprio(0); } while (0)
#define PG8_WAIT_V(n) asm volatile("s_waitcnt vmcnt(" #n ")" ::: "memory")
#define PG8_WAIT_L(n) asm volatile("s_waitcnt lgkmcnt(" #n ")" ::: "memory")
#define PG8_BAR __builtin_amdgcn_s_barrier()
#define PG8_SCHED __builtin_amdgcn_sched_barrier(0)
    Unit cur, nxt; int ui = 0;
    if (!S.next(0, cur)) return;
    f32x4 acc[2][2][4][2];
    float zacc = opaque_zero();
#pragma unroll
    for (int a = 0; a < 2; ++a)
#pragma unroll
        for (int b = 0; b < 2; ++b)
#pragma unroll
            for (int m = 0; m < 4; ++m)
#pragma unroll
                for (int n = 0; n < 2; ++n) { const float z = zacc; acc[a][b][m][n] = (f32x4){z, z, z, z}; }
    bf16x8 At[4][2], B0[2][2], B1[2][2];
    const char* cA = (const char*)g.A + (ptrdiff_t)Epi::a_row0(cur.pm) * (ptrdiff_t)rstepA; const char* cB = (const char*)g.Bt + (size_t)cur.pn * tstepB;
    if constexpr (Epi::HEADPF) E.head_dma(cur, 0);
    int ntu = nt, kt0u = 0;
    if constexpr (SK) { cA += (size_t)cur.kt0 * kstep; cB += (size_t)cur.kt0 * kstep; ntu = cur.ktn; kt0u = cur.kt0; }
    if constexpr (KG) E.kg_build((PG8_LAS float*)(lds + KG_TAB_OFF), cur);
    S.a_ready(cur);
    if constexpr (SP2) {
        PG8_STAGE(PG8_SB(0, 0), cB, voffB); PG8_STAGE(PG8_SB(0, 1), cB + hstepB, voffB); PG8_STAGE(PG8_SA(0, 0), cA, voffA); PG8_STAGE(PG8_SA(0, 1), cA + hstepA, voffA);
        if (wr == 1) PG8_BAR;
        PG8_WAIT_V(2); PG8_BAR;
        PG8_STAGE(PG8_SB(1, 0), cB + kstep, voffB); PG8_STAGE(PG8_SA(1, 0), cA + kstep, voffA); PG8_STAGE(PG8_SB(1, 1), cB + hstepB + kstep, voffB);
        PG8_WAIT_V(6); PG8_BAR;
    } else {
        PG8_STAGE(PG8_SB(0, 0), cB, voffB); PG8_STAGE(PG8_SA(0, 0), cA, voffA); PG8_STAGE(PG8_SB(0, 1), cB + hstepB, voffB); PG8_STAGE(PG8_SA(0, 1), cA + hstepA, voffA);
        if (wr == 1) PG8_BAR;
        PG8_WAIT_V(4); PG8_BAR;
        PG8_STAGE(PG8_SB(1, 0), cB + kstep, voffB); PG8_STAGE(PG8_SA(1, 0), cA + kstep, voffA); PG8_STAGE(PG8_SB(1, 1), cB + hstepB + kstep, voffB);
        PG8_WAIT_V(6); PG8_BAR;
    }
    for (;;) {
        const bool has_next = S.next(ui + 1, nxt);
        const char* nA = has_next ? (const char*)g.A + (ptrdiff_t)Epi::a_row0(nxt.pm) * (ptrdiff_t)rstepA : cA; const char* nB = has_next ? (const char*)g.Bt + (size_t)nxt.pn * tstepB : cB;
        if constexpr (SK) { if (has_next) { nA += (size_t)nxt.kt0 * kstep; nB += (size_t)nxt.kt0 * kstep; } }
        for (int t = 0; t < ntu; t += 2) {
            const bool last = (t == ntu - 2);
            const char* a1 = cA + (size_t)(t + 1) * kstep;
            const char* a2 = last ? nA : cA + (size_t)(t + 2) * kstep; const char* b2 = last ? nB : cB + (size_t)(t + 2) * kstep;
            const char* a3 = a2 + kstep; const char* b3 = b2 + kstep;
            if (last && has_next) S.a_ready(nxt);
            if constexpr (SP2) {
            PG8_LDB(B0, 0, 0); PG8_LDB(B1, 0, 1); PG8_SCHED; PG8_LDA(At, 0, 0); PG8_STAGE(PG8_SA(1, 1), a1 + hstepA, voffA);
            PG8_WAIT_V(8); PG8_WAIT_L(0); PG8_BAR; PG8_MMA(0, 0, At, B0); PG8_MMA(0, 1, At, B1); PG8_BAR; PG8_SCHED;
            PG8_LDA(At, 0, 1); PG8_STAGE(PG8_SB(0, 0), b2, voffB); PG8_STAGE(PG8_SB(0, 1), b2 + hstepB, voffB); PG8_STAGE(PG8_SA(0, 0), a2, voffA);
            PG8_WAIT_V(8); PG8_WAIT_L(0); PG8_BAR; PG8_MMA(1, 0, At, B0); PG8_MMA(1, 1, At, B1); PG8_BAR; PG8_SCHED;
            PG8_LDB(B0, 1, 0); PG8_LDB(B1, 1, 1); PG8_SCHED; PG8_LDA(At, 1, 0); PG8_STAGE(PG8_SA(0, 1), a2 + hstepA, voffA);
            PG8_WAIT_V(8); PG8_WAIT_L(0); PG8_BAR; PG8_MMA(0, 0, At, B0); PG8_MMA(0, 1, At, B1); PG8_BAR; PG8_SCHED;
            PG8_LDA(At, 1, 1); PG8_STAGE(PG8_SB(1, 0), b3, voffB); PG8_STAGE(PG8_SB(1, 1), b3 + hstepB, voffB); PG8_STAGE(PG8_SA(1, 0), a3, voffA);
            PG8_WAIT_V(8); PG8_WAIT_L(0); PG8_BAR; PG8_MMA(1, 0, At, B0); PG8_MMA(1, 1, At, B1); PG8_BAR; PG8_SCHED;
            } else {
            PG8_LDB(B0, 0, 0); PG8_SCHED; PG8_LDA(At, 0, 0); PG8_STAGE(PG8_SA(1, 1), a1 + hstepA, voffA);
            PG8_WAIT_L(8); PG8_BAR; PG8_WAIT_L(0); PG8_MMA(0, 0, At, B0); PG8_BAR; PG8_SCHED;
            PG8_LDB(B1, 0, 1); PG8_STAGE(PG8_SB(0, 0), b2, voffB);
            PG8_BAR; PG8_WAIT_L(0); PG8_MMA(0, 1, At, B1); PG8_BAR;
            PG8_LDA(At, 0, 1); PG8_STAGE(PG8_SA(0, 0), a2, voffA);
            PG8_BAR; PG8_WAIT_L(0); PG8_MMA(1, 0, At, B0); PG8_BAR; PG8_SCHED;
            PG8_STAGE(PG8_SB(0, 1), b2 + hstepB, voffB);
            PG8_WAIT_V(6); PG8_BAR; PG8_MMA(1, 1, At, B1); PG8_BAR;
            PG8_LDB(B0, 1, 0); PG8_SCHED; PG8_LDA(At, 1, 0); PG8_STAGE(PG8_SA(0, 1), a2 + hstepA, voffA);
            PG8_WAIT_L(8); PG8_BAR; PG8_WAIT_L(0); PG8_MMA(0, 0, At, B0); PG8_BAR; PG8_SCHED;
            PG8_LDB(B1, 1, 1); PG8_STAGE(PG8_SB(1, 0), b3, voffB);
            PG8_BAR; PG8_WAIT_L(0); PG8_MMA(0, 1, At, B1); PG8_BAR;
            PG8_LDA(At, 1, 1); PG8_STAGE(PG8_SA(1, 0), a3, voffA);
            PG8_BAR; PG8_WAIT_L(0); PG8_MMA(1, 0, At, B0); PG8_BAR; PG8_SCHED;
            PG8_STAGE(PG8_SB(1, 1), b3 + hstepB, voffB);
            PG8_WAIT_V(6); PG8_BAR; PG8_MMA(1, 1, At, B1); PG8_BAR;
            }
            if constexpr (KG) { const int ta = kt0u + t + 2; if ((ta & 7) == 0 && t + 2 < ntu) E.kg_rescale(acc, (const PG8_LAS float*)(lds + KG_TAB_OFF + (ui & 1) * KG_TAB_BYTES), ta >> 3, wr, fr); }
        }
        if constexpr (KG) E.kg_finish(acc, (const PG8_LAS float*)(lds + KG_TAB_OFF + (ui & 1) * KG_TAB_BYTES), (kt0u + ntu - 1) >> 3, wr, fr);
        if constexpr (ALIGN_EPI) { if (wr == 0) PG8_BAR; }
        if constexpr (Epi::HEADPF) { if (has_next) E.head_dma(nxt, (ui & 1) ^ 1); }
        if constexpr (SK) { bool ep = E.part_exchange(acc, cur); if (ep) { if constexpr (Epi::HEADPF) E(acc, cur, wr, wc, fr, fq, ui & 1); else E(acc, cur, wr, wc, fr, fq); } if (has_next) { ntu = nxt.ktn; kt0u = nxt.kt0; } }
        else if constexpr (Epi::HEADPF) { E(acc, cur, wr, wc, fr, fq, ui & 1); S.done(cur); }
        else if constexpr (!Epi::AFTER_DRAIN) { E(acc, cur, wr, wc, fr, fq); S.done(cur); }
        if (!has_next) break;
        zacc = opaque_zero();
#pragma unroll
        for (int a = 0; a < 2; ++a)
#pragma unroll
            for (int b = 0; b < 2; ++b)
#pragma unroll
                for (int m = 0; m < 4; ++m)
#pragma unroll
                    for (int n = 0; n < 2; ++n) { const float z = zacc; acc[a][b][m][n] = (f32x4){z, z, z, z}; }
        cur = nxt; cA = nA; cB = nB; ++ui;
        if constexpr (KG) E.kg_build((PG8_LAS float*)(lds + KG_TAB_OFF + (ui & 1) * KG_TAB_BYTES), cur);
        if constexpr (ALIGN_EPI) { if (wr == 1) PG8_BAR; }
    }
    PG8_WAIT_V(0);
    if constexpr (!ALIGN_EPI) { if (wr == 0) PG8_BAR; }
    PG8_BAR;
    if constexpr (Epi::AFTER_DRAIN) { E.fused(acc, cur, wr, wc, fr, fq, lds, wid, lane); S.done(cur); }
#undef PG8_SA
#undef PG8_SB
#undef PG8_STAGE
#undef PG8_LDA
#undef PG8_LDB
#undef PG8_MMA
#undef PG8_WAIT_V
#undef PG8_WAIT_L
#undef PG8_BAR
#undef PG8_SCHED
}
}

constexpr size_t MiB = 1u << 20;
constexpr size_t WS_CTL = 0, CTL_ZERO_BYTES = 3 * MiB;
constexpr size_t WS_SS = 256 * 1024;
static_assert(WS_SS + 9 * (size_t)MP * 8 <= CTL_ZERO_BYTES, "ctl map");
constexpr size_t WS_WT = 3 * MiB;
constexpr size_t WT_IN = 0, WT_OUT = (size_t)NINP * D, WT_UP = WT_OUT + (size_t)DI * D, WT_DOWN = WT_UP + (size_t)NUP * D, WT_ELEMS = WT_DOWN + (size_t)D * DFF;
constexpr size_t WT_BUF_BYTES = 124 * MiB;
constexpr size_t WS_H = WS_WT + 2 * WT_BUF_BYTES;
constexpr size_t H_PAD = 4 * (size_t)D * 2;
constexpr size_t WS_BIG = WS_H + 138 * MiB;
constexpr size_t WS_END = WS_BIG + 697 * MiB;
static_assert(WT_ELEMS * 2 <= 124 * MiB && H_PAD + (size_t)MP * D * 2 <= 138 * MiB, "ws map");
constexpr size_t BIG_BG = 0, BIG_CV = 138 * MiB, BIG_G = 412 * MiB;
static_assert((size_t)MP * D * 2 <= 138 * MiB && BIG_G + (size_t)MP * D * 2 <= 694 * MiB, "sc overlay");
constexpr size_t BIG_Z = 0, BIG_XBC = 274 * MiB, BIG_DT = BIG_XBC + 411 * MiB, BIG_RAWB = BIG_DT + 9 * MiB;
static_assert((size_t)MP * DI * 2 <= 274 * MiB && (size_t)MP * CONVD * 2 <= 411 * MiB && BIG_DT + (size_t)MP * NH * 4 <= BIG_RAWB && BIG_RAWB + (size_t)(NB + NS) * 3 * CONVD * 4 <= 697 * MiB, "ssd overlay");
constexpr size_t BIG_ACT = 0;
constexpr size_t BIG_SKP = 560 * MiB, SKP_BYTES = (size_t)255 * 2 * 256 * 256 * 4;
static_assert(BIG_G + (size_t)MP * D * 2 <= BIG_SKP && (size_t)MP * DI * 2 <= BIG_SKP && (size_t)MP * DFF * 2 <= BIG_SKP && BIG_SKP + SKP_BYTES <= 697 * MiB, "split-K scratch");
constexpr size_t SSG_OFF = 64 * MiB;
static_assert((size_t)128 * 2 * 256 * 256 * 4 <= SSG_OFF && SSG_OFF + (size_t)8 * MP * 8 <= WT_BUF_BYTES, "ssg");
constexpr size_t CTL_SKF = 32 * 1024; constexpr int SKF_WORDS = 128 * 64;
constexpr int SSD_ROW_TILES = 140;
static_assert(SSD_ROW_TILES * 250 >= T && SSD_ROW_TILES * 250 + 3 <= MP, "ssd tiles");
constexpr int FFN_ROW_TILES = 139;
static_assert((size_t)MP * DFF * 2 <= 694 * MiB && FFN_ROW_TILES * 252 >= T && FFN_ROW_TILES * 252 + 2 <= MP, "ffn overlay");
constexpr int CW_BAR = 4096;
static_assert((size_t)(CW_BAR + 3456) * 4 <= CTL_SKF && CTL_SKF + (size_t)7 * SKF_WORDS * 4 <= WS_SS, "ctl map");

constexpr int RING_OFF = 0, RING_BYTES = 131072;
constexpr int LDS_BYTES = 163840;
constexpr int LDSCTL_OFF = LDS_BYTES - 1024, MISC_OFF = LDSCTL_OFF + 320;
constexpr int EPI_WL_OFF = RING_BYTES;
constexpr int NWAVES = 8;

#define RLX_AGENT __ATOMIC_RELAXED, __HIP_MEMORY_SCOPE_AGENT
#define LDS_WAIT() asm volatile("s_waitcnt lgkmcnt(0)" ::: "memory")
#define VM_WAIT() asm volatile("s_waitcnt vmcnt(0)" ::: "memory")
typedef GAS unsigned gu32;

#define XB_TMO      128
#define XB_XCNT(j)  (256  + 64 * (j))
#define XB_XSUB(j)  (1280 + 64 * (j))
#define XB_XGEN(j)  (2304 + 64 * (j))
#define XB_TOP      3328
#define XB_TOPGEN   3392
#define XCD_BAR_WORDS 3456
#define XB_SPIN_CAP (1u << 18)

__device__ __forceinline__ unsigned xb_ld(unsigned* p)              { return __hip_atomic_load(p, __ATOMIC_RELAXED, __HIP_MEMORY_SCOPE_AGENT); }
__device__ __forceinline__ unsigned xb_add(unsigned* p, unsigned v) { return __hip_atomic_fetch_add(p, v, __ATOMIC_RELAXED, __HIP_MEMORY_SCOPE_AGENT); }
__device__ __forceinline__ unsigned xb_xcc_id() { return (unsigned)__builtin_amdgcn_s_getreg((3 << 11) | 20) & 0xFu; }
#define XB_SPIN(cond, bar) do { unsigned _sp = 0; while (cond) { __builtin_amdgcn_s_sleep(1); \
    if ((++_sp & 255u) == 0u) { if (xb_ld(&(bar)[XB_TMO])) break; if (_sp > XB_SPIN_CAP) { atomicAdd(&(bar)[XB_TMO], 1u); break; } } } } while (0)

struct XcdBarrier {
    unsigned* bar; unsigned x;
    volatile LAS unsigned* st;
};

__device__ __forceinline__ XcdBarrier xcd_barrier_post(unsigned* bar, volatile LAS unsigned* st) {
    XcdBarrier b; b.bar = bar; b.x = xb_xcc_id(); b.st = st;
    if (threadIdx.x == 0) (void)xb_add(&bar[XB_XCNT(b.x)], 1u);
    return b;
}
__device__ __forceinline__ void xcd_barrier_complete(unsigned* bar, unsigned x, unsigned& nloc, unsigned& nx) {
    const unsigned G = gridDim.x * gridDim.y * gridDim.z;
    unsigned sum, cnt, mine, sp = 0u;
    for (;;) {
        sum = 0u; cnt = 0u; mine = 0u;
#pragma unroll
        for (unsigned j = 0; j < 16; ++j) { const unsigned c = xb_ld(&bar[XB_XCNT(j)]); sum += c; cnt += (c > 0u) ? 1u : 0u; mine = (j == x) ? c : mine; }
        if (sum == G) break;
        __builtin_amdgcn_s_sleep(1);
        if ((++sp & 255u) == 0u) { if (xb_ld(&bar[XB_TMO])) break; if (sp > XB_SPIN_CAP) { atomicAdd(&bar[XB_TMO], 1u); break; } }
    }
    nloc = mine > 0u ? mine : 1u; nx = cnt > 0u ? cnt : 1u;
}

__device__ __forceinline__ void xcd_barrier(const XcdBarrier& b) {
    asm volatile("s_waitcnt vmcnt(0)" ::: "memory");
    __syncthreads();
    if (threadIdx.x == 0) {
        unsigned* bar = b.bar; asm volatile("" : "+s"(bar));
        unsigned bx = b.x; asm volatile("" : "+s"(bx));
        __builtin_amdgcn_s_waitcnt(0);
        unsigned nloc = b.st[0], nx = b.st[1];
        if (nloc == 0u) { xcd_barrier_complete(bar, bx, nloc, nx); b.st[0] = nloc; b.st[1] = nx; }
        const unsigned old = xb_add(&bar[XB_XSUB(bx)], 1u);
        const unsigned gen = old / nloc;
        if (old + 1u == (gen + 1u) * nloc) {
            __builtin_amdgcn_fence(__ATOMIC_RELEASE, "agent");
            asm volatile("s_waitcnt vmcnt(0)" ::: "memory");
            const unsigned og = xb_add(&bar[XB_TOP], 1u);
            const unsigned tg = og / nx;
            if (og + 1u == (tg + 1u) * nx) xb_add(&bar[XB_TOPGEN], 1u);
            else XB_SPIN(xb_ld(&bar[XB_TOPGEN]) == tg, bar);
            __builtin_amdgcn_fence(__ATOMIC_ACQUIRE, "agent");
            xb_add(&bar[XB_XGEN(bx)], 1u);
            asm volatile("s_waitcnt vmcnt(0)" ::: "memory");
        } else {
            XB_SPIN(xb_ld(&bar[XB_XGEN(bx)]) == gen, bar);
            __builtin_amdgcn_fence(__ATOMIC_ACQUIRE, "agent");
            asm volatile("s_waitcnt vmcnt(0)" ::: "memory");
        }
    }
    __syncthreads();
}


struct Params { const float* in[N_IN]; float* out; unsigned char* ws; };
struct Ctx {
    LAS unsigned char* lds;
    int tid, lane, wave, vcu, G;
};
__device__ __forceinline__ const float* ldp(const float* p) { asm volatile("" : "+s"(p)); return p; }
__device__ __forceinline__ Ctx refresh(const Ctx& F0) { Ctx F = F0; F.tid = opaque_i((int)threadIdx.x); F.lane = F.tid & 63; F.wave = __builtin_amdgcn_readfirstlane(F.tid >> 6); return F; }

__device__ __forceinline__ float wave_sum(float v, int lane) {
#pragma unroll
    for (int o = 1; o < 64; o <<= 1) v += shfl_from(v, lane ^ o);
    return v;
}

struct RowInfo { int seq, pos, L; bool sample; };
__device__ __forceinline__ RowInfo row_info(int r) {
    RowInfo ri;
    if (r < TP) { ri.sample = false; ri.seq = r / LP; ri.pos = r - ri.seq * LP; ri.L = LP; }
    else { const int q = r - TP; ri.sample = true; ri.seq = q >> 6; ri.pos = q & 63; ri.L = LS; }
    return ri;
}

template <int MODE = 0> __device__ __forceinline__ void transpose_item(const float* W, int K, int N, bf16* WT, const float* rowscale, LAS float* scr, int item, int lane) {
    const int nblk = N / 32, kb = item / nblk, nb = item - kb * nblk, k0 = 64 * kb, n0 = 32 * nb;
    const int d0 = MODE == 0 ? n0 : MODE == 1 ? (n0 < DFF ? 256 * (n0 >> 7) + (n0 & 127) : 256 * ((n0 - DFF) >> 7) + 128 + ((n0 - DFF) & 127))
                             : (n0 < D ? n0 : n0 < 2 * D ? D + 256 * ((n0 - D) >> 7) + ((n0 - D) & 127) : D + 256 * ((n0 - 2 * D) >> 7) + 128 + ((n0 - 2 * D) & 127));
    const int lr = lane >> 3, lc = (lane & 7) * 4;
    f32x4 v[8];
#pragma unroll
    for (int i = 0; i < 8; ++i) v[i] = *(const f32x4*)(W + (size_t)(k0 + lr + 8 * i) * N + n0 + lc);
    if (rowscale) {
#pragma unroll
        for (int i = 0; i < 8; ++i) v[i] = v[i] * rowscale[k0 + lr + 8 * i];
    }
#pragma unroll
    for (int i = 0; i < 8; ++i) { LAS float* d = scr + (lr + 8 * i) * 33 + lc; d[0] = v[i].x; d[1] = v[i].y; d[2] = v[i].z; d[3] = v[i].w; }
    LDS_WAIT(); asm volatile("" ::: "memory");
    const int c = lane & 7;
#pragma unroll
    for (int j = 0; j < 4; ++j) { const int n = (lane >> 3) + 8 * j; const LAS float* s = scr + (8 * c) * 33 + n;
        v4u o; o.x = pk2(s[0 * 33], s[1 * 33]); o.y = pk2(s[2 * 33], s[3 * 33]); o.z = pk2(s[4 * 33], s[5 * 33]); o.w = pk2(s[6 * 33], s[7 * 33]);
        *(v4u*)(WT + (size_t)(d0 + n) * K + k0 + 8 * c) = o; }
    LDS_WAIT(); asm volatile("" ::: "memory");
}
__device__ __forceinline__ void convert_layer_weights(const Ctx& F0, const Params& P, int layer, int wg0) {
    if ((int)blockIdx.x < wg0) return;
    const Ctx F = refresh(F0);
    LAS float* scr = (LAS float*)(F.lds + RING_OFF + F.wave * 16384);
    bf16* WT = (bf16*)(P.ws + WS_WT + (size_t)(layer & 1) * WT_BUF_BYTES);
    const int gw = ((int)blockIdx.x - wg0) * NWAVES + F.wave, NGW = (F.G - wg0) * NWAVES;
    const int j = layer >> 1; const bool ssd = layer & 1;
    const float* p_ssd_in = ldp(P.in[I_SSD_WIN]); const float* p_sc_in = ldp(P.in[I_SC_WIN]); const float* p_ssd_out = ldp(P.in[I_SSD_WOUT]); const float* p_sc_out = ldp(P.in[I_SC_WOUT]);
    const float* w_in  = ssd ? p_ssd_in + (size_t)j * D * NIN : p_sc_in + (size_t)j * D * 3 * D;
    const float* w_out = ssd ? p_ssd_out + (size_t)j * DI * D : p_sc_out + (size_t)j * D * D;
    const float* w_up = P.in[I_FFN_WUP] + (size_t)layer * D * NUP;
    const float* w_dn = P.in[I_FFN_WDOWN] + (size_t)layer * DFF * D;
    const float* g_ssdn = P.in[I_SSD_NW] + (size_t)j * DI;
    const float* g_mix = P.in[I_NMIX] + (size_t)layer * D; const float* g_ffn = P.in[I_NFFN] + (size_t)layer * D;
    const int n_in = ssd ? NIN : 3 * D, k_out = ssd ? DI : D;
    const int it_in = (D / 64) * (n_in / 32), it_out = (k_out / 64) * (D / 32), it_up = (D / 64) * (NUP / 32), it_dn = (DFF / 64) * (D / 32);
    const int total = it_in + it_out + it_up + it_dn;
    for (int it = gw; it < total; it += NGW) {
        int r = it;
        if (r < it_in) { if (ssd) transpose_item<0>(w_in, D, n_in, WT + WT_IN, g_mix, scr, r, F.lane); else transpose_item<2>(w_in, D, n_in, WT + WT_IN, g_mix, scr, r, F.lane); continue; } r -= it_in;
        if (r < it_out) { transpose_item(w_out, k_out, D, WT + WT_OUT, ssd ? g_ssdn : nullptr, scr, r, F.lane); continue; } r -= it_out;
        if (r < it_up) { transpose_item<1>(w_up, D, NUP, WT + WT_UP, g_ffn, scr, r, F.lane); continue; } r -= it_up;
        transpose_item(w_dn, DFF, D, WT + WT_DOWN, nullptr, scr, r, F.lane);
    }
    if (ssd) {
        const int gt = gw * 64 + F.lane, NT = NGW * 64; const unsigned zz = __builtin_bit_cast(unsigned, opaque_zero()); v4u z = {zz, zz, zz, zz};
        v4u* pz = (v4u*)(WT + WT_IN + (size_t)NIN * D);
        for (int i = gt; i < (NINP - NIN) * D / 8; i += NT) pz[i] = z;
    }
}

__device__ __forceinline__ const float* src_row0(const Params& P, int r) {
    if (r < TP) { const int b = r / LP, pos = r - b * LP;
        return pos < NMETA ? P.in[I_META] + (size_t)pos * D : P.in[I_XP] + ((size_t)b * SEQ + (pos - NMETA)) * D; }
    return P.in[I_XS] + (size_t)(r - TP) * D;
}
__device__ __forceinline__ void embed_phase(const Ctx& F0, const Params& P) {
    const Ctx F = refresh(F0);
    bf16* H = (bf16*)(P.ws + WS_H + H_PAD); unsigned long long* ss = (unsigned long long*)(P.ws + WS_SS);
    const int gw = F.vcu * NWAVES + F.wave, NGW = F.G * NWAVES;
    for (int m = gw; m < MP; m += NGW) {
        v2u* ho = (v2u*)(H + (size_t)m * D);
        if (m < T) {
            const f32x4* xr = (const f32x4*)src_row0(P, m);
            f32x4 v[8]; float s = 0.f;
#pragma unroll
            for (int j = 0; j < 8; ++j) v[j] = xr[F.lane + 64 * j];
#pragma unroll
            for (int j = 0; j < 8; ++j) { v2u q; q.x = pk2(v[j].x, v[j].y); q.y = pk2(v[j].z, v[j].w); ho[F.lane + 64 * j] = q;
                const float r0 = bflo(q.x), r1 = bfhi(q.x), r2 = bflo(q.y), r3 = bfhi(q.y); s += (r0 * r0 + r1 * r1) + (r2 * r2 + r3 * r3); }
            s = wave_sum(s, F.lane);
            if (F.lane == 0) ss[m] = (unsigned long long)(s * 1048576.0f + 0.5f);
        } else {
            const unsigned zu = __builtin_bit_cast(unsigned, opaque_zero());
#pragma unroll
            for (int j = 0; j < 8; ++j) ho[F.lane + 64 * j] = (v2u){zu, zu};
        }
    }
}
__device__ __forceinline__ void final_norm_phase(const Ctx& F0, const Params& P) {
    const Ctx F = refresh(F0);
    const bf16* H = (const bf16*)(P.ws + WS_H + H_PAD); const float* w = P.in[I_NFINAL];
    const int gw = F.vcu * NWAVES + F.wave, NGW = F.G * NWAVES;
    f32x4 wv[8];
#pragma unroll
    for (int j = 0; j < 8; ++j) wv[j] = ((const f32x4*)w)[F.lane + 64 * j];
    for (int m = gw; m < T; m += NGW) {
        float* orow;
        if (m < TP) { const int b = m / LP, pos = m - b * LP; if (pos < NMETA) continue; orow = P.out + O_YP + ((size_t)b * SEQ + (pos - NMETA)) * D; }
        else orow = P.out + O_YS + (size_t)(m - TP) * D;
        const v2u* xr = (const v2u*)(H + (size_t)m * D);
        f32x4 v[8]; float s = 0.f;
#pragma unroll
        for (int j = 0; j < 8; ++j) { const v2u q = xr[F.lane + 64 * j]; v[j] = (f32x4){bflo(q.x), bfhi(q.x), bflo(q.y), bfhi(q.y)}; s += (v[j].x * v[j].x + v[j].y * v[j].y) + (v[j].z * v[j].z + v[j].w * v[j].w); }
        const float rstd = 1.0f / sqrtf(wave_sum(s, F.lane) * (1.0f / D) + EPS);
#pragma unroll
        for (int j = 0; j < 8; ++j) ((f32x4*)orow)[F.lane + 64 * j] = v[j] * rstd * wv[j];
    }
}

__device__ __forceinline__ void unpack8(const v4u q, float (&f)[8]) {
    f[0] = bflo(q.x); f[1] = bfhi(q.x); f[2] = bflo(q.y); f[3] = bfhi(q.y); f[4] = bflo(q.z); f[5] = bfhi(q.z); f[6] = bflo(q.w); f[7] = bfhi(q.w);
}
__device__ __forceinline__ void sc_gate_phase(const Ctx& F0, const Params& P, int j) {
    const Ctx F = refresh(F0);
    const bf16* BG = (const bf16*)(P.ws + WS_BIG + BIG_BG); const bf16* CV = (const bf16*)(P.ws + WS_BIG + BIG_CV); bf16* G = (bf16*)(P.ws + WS_BIG + BIG_G);
    const float* cw = P.in[I_SC_CW] + (size_t)j * 3 * D;
    const float* st = P.in[I_ST_CONVA] + (size_t)j * NS * 2 * D;
    const int gt = (F.vcu * NWAVES + F.wave) * 64 + F.lane, NT = F.G * NWAVES * 64;
    static_assert(LP % 4 == 0 && LS % 4 == 0 && TP % 4 == 0 && T % 4 == 0, "4-row strips");
    for (int idx = gt; idx < (T / 4) * 256; idx += NT) {
        const int r0 = (idx >> 8) * 4, c0 = (idx & 255) * 8;
        const RowInfo ri = row_info(r0);
        const int rm2 = max(r0 - 2, 0);
        v4u qb[4], qc[6];
#pragma unroll
        for (int i = 0; i < 4; ++i) qb[i] = *(const v4u*)(BG + (size_t)(r0 + i) * D + c0);
#pragma unroll
        for (int i = 0; i < 6; ++i) qc[i] = *(const v4u*)(CV + (size_t)(rm2 + i) * D + c0);
        const f32x4 w0l = *(const f32x4*)(cw + c0), w0h = *(const f32x4*)(cw + c0 + 4), w1l = *(const f32x4*)(cw + D + c0), w1h = *(const f32x4*)(cw + D + c0 + 4), w2l = *(const f32x4*)(cw + 2 * D + c0), w2h = *(const f32x4*)(cw + 2 * D + c0 + 4);
        const float w0[8] = {w0l[0], w0l[1], w0l[2], w0l[3], w0h[0], w0h[1], w0h[2], w0h[3]}, w1[8] = {w1l[0], w1l[1], w1l[2], w1l[3], w1h[0], w1h[1], w1h[2], w1h[3]}, w2[8] = {w2l[0], w2l[1], w2l[2], w2l[3], w2h[0], w2h[1], w2h[2], w2h[3]};
        float cv[6][8];
#pragma unroll
        for (int i = 0; i < 6; ++i) unpack8(qc[i], cv[i]);
        if (r0 < 2) {
#pragma unroll
            for (int i = 5; i >= 2; --i)
#pragma unroll
                for (int e = 0; e < 8; ++e) cv[i][e] = cv[i - 2][e];
        }
        if (ri.pos == 0) {
            if (ri.sample) { const float* s = st + (size_t)ri.seq * 2 * D + c0;
#pragma unroll
                for (int e = 0; e < 8; ++e) { cv[0][e] = s[e]; cv[1][e] = s[D + e]; } }
            else {
#pragma unroll
                for (int e = 0; e < 8; ++e) { cv[0][e] = 0.f; cv[1][e] = 0.f; } }
        }
#pragma unroll
        for (int i = 0; i < 4; ++i) {
            float bg[8], g[8]; unpack8(qb[i], bg);
#pragma unroll
            for (int e = 0; e < 8; ++e) g[e] = bg[e] * (w0[e] * cv[i][e] + w1[e] * cv[i + 1][e] + w2[e] * cv[i + 2][e]);
            v4u o; o.x = pk2(g[0], g[1]); o.y = pk2(g[2], g[3]); o.z = pk2(g[4], g[5]); o.w = pk2(g[6], g[7]);
            *(v4u*)(G + (size_t)(r0 + i) * D + c0) = o;
        }
        if (ri.pos == ri.L - 4) {
#pragma unroll
            for (int k = 0; k < 2; ++k) {
                float* ob = ri.sample ? P.out + O_SCONVA + (((size_t)j * NS + ri.seq) * 2 + k) * D + c0 : P.out + O_PCONVA + (((size_t)j * NB + ri.seq) * 2 + k) * D + c0;
                *(f32x4*)ob = (f32x4){cv[4 + k][0], cv[4 + k][1], cv[4 + k][2], cv[4 + k][3]}; *(f32x4*)(ob + 4) = (f32x4){cv[4 + k][4], cv[4 + k][5], cv[4 + k][6], cv[4 + k][7]};
            }
        }
    }
}


constexpr int SC_TILE = 53248;
constexpr int SC_X = 0, SC_XW = 9216, SC_B = 18432, SC_C = 35840;
constexpr int SC_S = 2 * SC_TILE;
constexpr int SC_PB = SC_S + 2 * 17408;
constexpr int SC_DT = SC_PB + 9216;
constexpr int SC_END = SC_DT + 3 * 1024;
static_assert(SC_END <= LDSCTL_OFF, "scan LDS");
#define SCAN_BAR() do { asm volatile("s_waitcnt lgkmcnt(0)" ::: "memory"); __builtin_amdgcn_s_barrier(); asm volatile("" ::: "memory"); } while (0)
#define MFMA32(a, b, c) __builtin_amdgcn_mfma_f32_32x32x16_bf16((a), (b), (c), 0, 0, 0)
typedef short s16x4 __attribute__((ext_vector_type(4)));

__device__ __forceinline__ bf16x8 mk8s(s16x4 a, s16x4 b) { return __builtin_shufflevector(a, b, 0, 1, 2, 3, 4, 5, 6, 7); }
__device__ __forceinline__ s16x4 tr_read(LAS unsigned char* p) { return __builtin_amdgcn_ds_read_tr16_b64_v4i16((LAS s16x4*)p); }

__device__ __forceinline__ void ssd_scan_phase(const Ctx& F0, const Params& P, int j2, bool dry, unsigned long long* ssg) {
    const Ctx F = refresh(F0);
    LAS unsigned char* lds = F.lds + RING_OFF;
    bf16* Z = (bf16*)(P.ws + WS_BIG + BIG_Z); const bf16* XBC = (const bf16*)(P.ws + WS_BIG + BIG_XBC); const float* DT = (const float*)(P.ws + WS_BIG + BIG_DT);
    const int wave = F.wave;

    for (int ch = F.vcu; ch < NB * NH + NS * NH; ch += F.G) {
        const int tid = opaque_i(F.tid), lane = tid & 63, r = lane & 31, h = lane >> 5;
        const bool sample = ch >= NB * NH;
        const int cidx = sample ? ch - NB * NH : ch;
        const int b = cidx >> 6, hd = cidx & 63, g = hd >> 3;
        const int L = sample ? LS : LP, row0 = sample ? TP + b * LS : b * LP;
        const int nchunks = (L + 63) >> 6;
        const float Ah = -__expf(P.in[I_SSD_ALOG][j2 * NH + hd]), Dh = P.in[I_SSD_D][j2 * NH + hd];
        const int wq = wave & 3, pbY = wq >> 1, ibY = wq & 1;

        __syncthreads();
        f32x16 sacc[2];
#pragma unroll
        for (int pb = 0; pb < 2; ++pb)
#pragma unroll
            for (int i = 0; i < 16; ++i) sacc[pb][i] = 0.f;
        if (wave >= 4) {
            const int nb = wq;
            if (sample) {
                const float* s0 = P.in[I_ST_SSD] + (((size_t)j2 * NS + b) * NH + hd) * (HD * NST);
#pragma unroll
                for (int pb = 0; pb < 2; ++pb)
#pragma unroll
                    for (int q = 0; q < 4; ++q) { const f32x4 v = *(const f32x4*)(s0 + (size_t)(32 * pb + r) * NST + 32 * nb + 8 * q + 4 * h);
                        sacc[pb][4 * q] = v.x; sacc[pb][4 * q + 1] = v.y; sacc[pb][4 * q + 2] = v.z; sacc[pb][4 * q + 3] = v.w; }
            }
#pragma unroll
            for (int pb = 0; pb < 2; ++pb)
#pragma unroll
                for (int q = 0; q < 4; ++q) { v2u w; w.x = pk2(sacc[pb][4 * q], sacc[pb][4 * q + 1]); w.y = pk2(sacc[pb][4 * q + 2], sacc[pb][4 * q + 3]);
                    *(LAS v2u*)(lds + SC_S + 17408 + (32 * pb + r) * 272 + (32 * nb + 8 * q + 4 * h) * 2) = w; }
        }
        auto dt_calc = [&](int c, float raw) {
            const float dtv = (64 * c + lane < L) ? raw : 0.f;
            float a = dtv * Ah;
#pragma unroll
            for (int o = 1; o < 64; o <<= 1) { const float t = shfl_from(a, (lane - o) & 63); a += (lane >= o) ? t : 0.f; }
            const float last = shfl_from(a, 63);
            LAS float* db = (LAS float*)(lds + SC_DT + (c % 3) * 1024);
            db[lane] = a; db[64 + lane] = dtv; db[128 + lane] = __expf(last - a) * dtv;
            if (lane == 0) db[192] = __expf(last);
        };
        auto dt_load = [&](int c) -> float {
            const int pos = 64 * c + lane; return DT[(size_t)(row0 + min(pos, L - 1)) * NH + hd];
        };
        { const float d0 = dt_load(0), d1 = dt_load(min(1, nchunks - 1));
          if (wave == 3) { dt_calc(0, d0); if (nchunks > 1) dt_calc(1, d1); } }
        float dtr = dt_load(min(2, nchunks - 1));

        v4u gx, gb0, gb1, gc0, gc1;
        const int xrow = tid >> 3, xch = tid & 7, brow = tid >> 4, bch = tid & 15;
        const char* ub = (const char*)XBC + (size_t)row0 * (CONVD * 2);
        const unsigned vox = (unsigned)(xrow * CONVD + hd * 64 + 8 * xch) * 2u, vob = (unsigned)(brow * CONVD + DI + g * 128 + 8 * bch) * 2u;
        auto prefetch = [&](int c) {
            const char* uc = ub + (size_t)c * (64 * CONVD * 2);
            gx = *(const v4u*)(uc + vox);
            gb0 = *(const v4u*)(uc + vob); gc0 = *(const v4u*)(uc + vob + NG * NST * 2);
            gb1 = *(const v4u*)(uc + 32 * (CONVD * 2) + vob); gc1 = *(const v4u*)(uc + 32 * (CONVD * 2) + vob + NG * NST * 2);
        };
        auto stage = [&](int c) {
            LAS unsigned char* tb = lds + (c & 1) * SC_TILE;
            const LAS float* dbc = (const LAS float*)(lds + SC_DT + (c % 3) * 1024);
            const v4u zero4 = {0u, 0u, 0u, 0u};
            if (64 * c + xrow >= L) gx = zero4;
            if (64 * c + brow >= L) { gb0 = zero4; gc0 = zero4; }
            if (64 * c + brow + 32 >= L) { gb1 = zero4; gc1 = zero4; }
            *(LAS v4u*)(tb + SC_X + xrow * 144 + 16 * xch) = gx;
            const float wt = dbc[128 + xrow];
            v4u xw; xw.x = pk2(bflo(gx.x) * wt, bfhi(gx.x) * wt); xw.y = pk2(bflo(gx.y) * wt, bfhi(gx.y) * wt); xw.z = pk2(bflo(gx.z) * wt, bfhi(gx.z) * wt); xw.w = pk2(bflo(gx.w) * wt, bfhi(gx.w) * wt);
            *(LAS v4u*)(tb + SC_XW + xrow * 144 + 16 * xch) = xw;
            *(LAS v4u*)(tb + SC_B + brow * 272 + 16 * bch) = gb0; *(LAS v4u*)(tb + SC_B + (brow + 32) * 272 + 16 * bch) = gb1;
            *(LAS v4u*)(tb + SC_C + brow * 272 + 16 * bch) = gc0; *(LAS v4u*)(tb + SC_C + (brow + 32) * 272 + 16 * bch) = gc1;
        };
        prefetch(0);
        v2u zn[4];
        {
            const int pos = min(32 * ibY + r, L - 1);
            const bf16* zr = Z + (size_t)(row0 + pos) * DI + hd * 64 + 32 * pbY + 4 * h;
#pragma unroll
            for (int q = 0; q < 4; ++q) zn[q] = *(const v2u*)(zr + 8 * q);
        }
        {
            const float* cwp = P.in[I_SSD_CW] + (size_t)j2 * 4 * CONVD; const float* cbp = P.in[I_SSD_CB] + (size_t)j2 * CONVD;
            const float* stc = P.in[I_ST_SSDCONV] + ((size_t)j2 * NS + b) * 3 * CONVD;
            const float* rawq = (const float*)(P.ws + WS_BIG + BIG_RAWB) + (size_t)(sample ? NB + b : b) * 3 * CONVD;
            auto fix8 = [&](int pos, int col0) -> v4u {
                f32x4 rw[4][2], sw[4][2], ww[4][2], bb[2];
#pragma unroll
                for (int k = 0; k < 4; ++k) {
                    const int p = pos - 3 + k, pr = max(p, 0), ps = min(max(3 + p, 0), 2);
#pragma unroll
                    for (int hh = 0; hh < 2; ++hh) {
                        rw[k][hh] = *(const f32x4*)(rawq + (size_t)pr * CONVD + col0 + 4 * hh);
                        sw[k][hh] = *(const f32x4*)(stc + (size_t)ps * CONVD + col0 + 4 * hh);
                        ww[k][hh] = *(const f32x4*)(cwp + (size_t)k * CONVD + col0 + 4 * hh);
                    }
                }
                bb[0] = *(const f32x4*)(cbp + col0); bb[1] = *(const f32x4*)(cbp + col0 + 4);
                float o[8];
#pragma unroll
                for (int e = 0; e < 8; ++e) {
                    float s = bb[e >> 2][e & 3];
#pragma unroll
                    for (int k = 0; k < 4; ++k) { const int p = pos - 3 + k; const float v = (p >= 0) ? rw[k][e >> 2][e & 3] : (sample ? sw[k][e >> 2][e & 3] : 0.f); s += ww[k][e >> 2][e & 3] * v; }
                    o[e] = silu_f(s);
                }
                v4u w; w.x = pk2(o[0], o[1]); w.y = pk2(o[2], o[3]); w.z = pk2(o[4], o[5]); w.w = pk2(o[6], o[7]); return w;
            };
            if (xrow < 3) gx = fix8(xrow, hd * 64 + 8 * xch);
            if (brow < 3) { gb0 = fix8(brow, DI + g * 128 + 8 * bch); gc0 = fix8(brow, DI + NG * NST + g * 128 + 8 * bch); }
        }
        __syncthreads();
        stage(0);
        prefetch(min(1, nchunks - 1));
        SCAN_BAR();

        const int g16 = (lane >> 4) & 1, li = lane & 15, tq = li >> 2, tp = li & 3;
        for (int c = 0; c < nchunks; ++c) {
            const LAS float* db = (const LAS float*)(lds + SC_DT + (c % 3) * 1024);
            LAS unsigned char* tb = lds + (c & 1) * SC_TILE;
            if (c + 1 < nchunks) stage(c + 1);
            prefetch(min(c + 2, nchunks - 1));
            f32x16 y2;
#pragma unroll
            for (int i = 0; i < 16; ++i) y2[i] = 0.f;
            if (wave < 3) {
                const int jb = wave >> 1, ib = (wave + 1) >> 1;
                f32x16 gt;
#pragma unroll
                for (int i = 0; i < 16; ++i) gt[i] = 0.f;
#pragma unroll
                for (int s = 0; s < 8; ++s) {
                    const bf16x8 a = *(const LAS bf16x8*)(tb + SC_B + (32 * jb + r) * 272 + (16 * s + 8 * h) * 2);
                    const bf16x8 cfr = *(const LAS bf16x8*)(tb + SC_C + (32 * ib + r) * 272 + (16 * s + 8 * h) * 2);
                    gt = MFMA32(a, cfr, gt);
                }
                const int tok = 32 * ib + r; const float cs_i = db[tok];
#pragma unroll
                for (int q = 0; q < 4; ++q) {
                    const int j0 = 32 * jb + 8 * q + 4 * h;
                    const f32x4 csj = *(const LAS f32x4*)(db + j0), dtj = *(const LAS f32x4*)(db + 64 + j0);
                    float pv[4];
#pragma unroll
                    for (int e = 0; e < 4; ++e) {
                        const int jj = j0 + e;
                        float v = gt[4 * q + e] * __expf(fminf(cs_i - csj[e], 0.f)) * dtj[e];
                        v = (jj <= tok) ? v : 0.f;
                        v += (jj == tok) ? Dh : 0.f;
                        pv[e] = v;
                    }
                    v2u w; w.x = pk2(pv[0], pv[1]); w.y = pk2(pv[2], pv[3]);
                    *(LAS v2u*)(lds + SC_PB + tok * 144 + j0 * 2) = w;
                }
            } else if (wave == 3) {
                if (c + 2 < nchunks) dt_calc(c + 2, dtr);
            } else {
                const int nb = wq;
                const int sbuf = (c + 1) & 1;
#pragma unroll
                for (int s = 0; s < 8; ++s) {
                    const bf16x8 a = *(const LAS bf16x8*)(lds + SC_S + sbuf * 17408 + (32 * pbY + r) * 272 + (16 * s + 8 * h) * 2);
                    const bf16x8 cfr = *(const LAS bf16x8*)(tb + SC_C + (32 * ibY + r) * 272 + (16 * s + 8 * h) * 2);
                    y2 = MFMA32(a, cfr, y2);
                }
                const float dS = db[192];
#pragma unroll
                for (int pb = 0; pb < 2; ++pb)
#pragma unroll
                    for (int i = 0; i < 16; ++i) sacc[pb][i] *= dS;
#pragma unroll
                for (int s = 0; s < 4; ++s) {
                    const int R0 = 16 * s + 8 * h;
                    LAS unsigned char* ba = tb + SC_B + (R0 + tq) * 272 + (32 * nb + 16 * g16 + 4 * tp) * 2;
                    const bf16x8 af = mk8s(tr_read(ba), tr_read(ba + 4 * 272));
#pragma unroll
                    for (int pb = 0; pb < 2; ++pb) {
                        LAS unsigned char* xb = tb + SC_XW + (R0 + tq) * 144 + (32 * pb + 16 * g16 + 4 * tp) * 2;
                        sacc[pb] = MFMA32(af, mk8s(tr_read(xb), tr_read(xb + 4 * 144)), sacc[pb]);
                    }
                }
                const int wbuf = c & 1;
#pragma unroll
                for (int pb = 0; pb < 2; ++pb)
#pragma unroll
                    for (int q = 0; q < 4; ++q) { v2u w; w.x = pk2(sacc[pb][4 * q], sacc[pb][4 * q + 1]); w.y = pk2(sacc[pb][4 * q + 2], sacc[pb][4 * q + 3]);
                        *(LAS v2u*)(lds + SC_S + wbuf * 17408 + (32 * pb + r) * 272 + (32 * nb + 8 * q + 4 * h) * 2) = w; }
            }
            dtr = dt_load(min(c + 3, nchunks - 1));
            SCAN_BAR();
            if (wave >= 4) {
                const int tok = 32 * ibY + r, pos = 64 * c + tok; const bool valid = pos < L;
                bf16* zrow = Z + (size_t)(row0 + pos) * DI + hd * 64 + 32 * pbY + 4 * h;
                f32x16 y1;
#pragma unroll
                for (int i = 0; i < 16; ++i) y1[i] = 0.f;
#pragma unroll
                for (int jb = 0; jb < 2; ++jb) {
                    if (jb <= ibY) {
#pragma unroll
                        for (int s2 = 0; s2 < 2; ++s2) {
                            const int R0 = 32 * jb + 16 * s2 + 8 * h;
                            LAS unsigned char* xa = tb + SC_X + (R0 + tq) * 144 + (32 * pbY + 16 * g16 + 4 * tp) * 2;
                            const bf16x8 af = mk8s(tr_read(xa), tr_read(xa + 4 * 144));
                            const bf16x8 pf = *(const LAS bf16x8*)(lds + SC_PB + tok * 144 + R0 * 2);
                            y1 = MFMA32(af, pf, y1);
                        }
                    }
                }
                const float ecs = __expf(db[tok]);
                float ssq = 0.f;
                if (valid && !dry) {
#pragma unroll
                    for (int q = 0; q < 4; ++q) {
                        const float z0 = bflo(zn[q].x), z1 = bfhi(zn[q].x), z2 = bflo(zn[q].y), z3 = bfhi(zn[q].y);
                        const float o0 = (y1[4 * q] + ecs * y2[4 * q]) * silu_f(z0), o1 = (y1[4 * q + 1] + ecs * y2[4 * q + 1]) * silu_f(z1);
                        const float o2 = (y1[4 * q + 2] + ecs * y2[4 * q + 2]) * silu_f(z2), o3 = (y1[4 * q + 3] + ecs * y2[4 * q + 3]) * silu_f(z3);
                        v2u w; w.x = pk2(o0, o1); w.y = pk2(o2, o3);
                        *(v2u*)(zrow + 8 * q) = w;
                        const float r0 = bflo(w.x), r1 = bfhi(w.x), r2 = bflo(w.y), r3 = bfhi(w.y);
                        ssq += (r0 * r0 + r1 * r1) + (r2 * r2 + r3 * r3);
                    }
                }
                ssq += shfl_from(ssq, lane ^ 32);
                if (valid && !dry && h == 0) atomicAdd(ssg + (size_t)g * MP + row0 + pos, (unsigned long long)(ssq * 1048576.0f + 0.5f));
                {
                    const int posn = min(64 * min(c + 1, nchunks - 1) + tok, L - 1);
                    const bf16* zr = Z + (size_t)(row0 + posn) * DI + hd * 64 + 32 * pbY + 4 * h;
#pragma unroll
                    for (int q = 0; q < 4; ++q) zn[q] = *(const v2u*)(zr + 8 * q);
                }
            }
            SCAN_BAR();
        }
        if (wave >= 4 && !dry) {
            const int nb = wq;
            float* so = sample ? P.out + O_SSSD + (((size_t)j2 * NS + b) * NH + hd) * (HD * NST) : P.out + O_PSSD + (((size_t)j2 * NB + b) * NH + hd) * (HD * NST);
#pragma unroll
            for (int pb = 0; pb < 2; ++pb)
#pragma unroll
                for (int q = 0; q < 4; ++q) { f32x4 v = {sacc[pb][4 * q], sacc[pb][4 * q + 1], sacc[pb][4 * q + 2], sacc[pb][4 * q + 3]};
                    *(f32x4*)(so + (size_t)(32 * pb + r) * NST + 32 * nb + 8 * q + 4 * h) = v; }
        }
    }
}

#ifndef WGM_STORE
#define WGM_STORE 6
#endif
#ifndef WGM_G1
#define WGM_G1 WGM_STORE
#endif
#ifndef WGM_G5
#define WGM_G5 WGM_STORE
#endif
#ifndef WGM_G3
#define WGM_G3 5
#endif
#ifndef WGM_RES
#define WGM_RES 2
#endif
__global__ void __launch_bounds__(NWAVES * 64, 2) hybrid_fwd(Params P) {
    extern __shared__ __attribute__((aligned(16))) unsigned char lds_raw[];
    Ctx F;
    F.lds = (LAS unsigned char*)lds_raw;
    F.tid = threadIdx.x; F.lane = F.tid & 63; F.wave = __builtin_amdgcn_readfirstlane(F.tid >> 6);
    F.G = gridDim.x; { const int bx = blockIdx.x; F.vcu = (F.G % 8 == 0) ? (bx % 8) * (F.G / 8) + bx / 8 : bx; }
    volatile LAS unsigned* MISC = (volatile LAS unsigned*)(F.lds + MISC_OFF);
    for (int u = F.tid; u < (LDS_BYTES - LDSCTL_OFF) / 4; u += NWAVES * 64) ((LAS unsigned*)(F.lds + LDSCTL_OFF))[u] = 0u;
    __syncthreads();
    XcdBarrier bar = xcd_barrier_post((unsigned*)(P.ws + WS_CTL) + CW_BAR, MISC + 8);

    bf16* const H = (bf16*)(P.ws + WS_H + H_PAD);
    unsigned char* const BIG = P.ws + WS_BIG;

    unsigned long long* const SS = (unsigned long long*)(P.ws + WS_SS);
    for (int rp = 0; rp < ((PROBE & 1) ? 2 : 1); ++rp) { embed_phase(F, P); if (PROBE & 1) xcd_barrier(bar); }
    convert_layer_weights(F, P, 0, 0);
    xcd_barrier(bar);
    for (int layer = 0; layer < 4; ++layer) {
        const int j = layer >> 1; const bool ssd = layer & 1;
        bf16* const WT = (bf16*)(P.ws + WS_WT + (size_t)(layer & 1) * WT_BUF_BYTES);
        if (!ssd) {
            pg8::Gemm g{H, WT + WT_IN, MP, 3 * D, D};
            pg8::RowOrder S; S.init(0, MP / 256, g.N / 256, F.G, opaque_s((int)blockIdx.x)); S.wgm = WGM_G1; S.rev = 1;
            pg8::EpiStore E; E.O1 = (bf16*)(BIG + BIG_BG); E.ld1 = D; E.n1 = 8; E.O2 = (bf16*)(BIG + BIG_CV); E.ld2 = D; E.n2 = 24; E.F3 = nullptr; E.ld3 = 0; E.ncv0 = 8;
            E.ss = SS + (size_t)(2 * layer) * MP;
            constexpr int NR = 1 + ((PROBE & 4) ? 1 : 0) + ((PROBE & 16) ? 1 : 0);
            for (int rp = 0; rp < NR; ++rp) { E.dry = ((PROBE & 16) && rp == 0) ? 1 : 0; pg8::gemm_phase<pg8::EpiStore, pg8::RowOrder, true, true>(F.lds + RING_OFF, g, S, E); xcd_barrier(bar); }
        } else {
            pg8::Gemm g{H, WT + WT_IN, MP, NINP, D};
            pg8::RowOrder S; S.init(0, SSD_ROW_TILES, NINP / 256, F.G, opaque_s((int)blockIdx.x)); S.wgm = WGM_G5; S.rev = 1;
            const int Gs = opaque_s(F.G), rem = S.nwg % Gs; S.lim = S.nwg - rem;
            pg8::RowOrderSK SK{S, S.lim, rem ? min(pg8::SK_MAXPARTS, Gs / rem) : 1, g.K / pg8::BK};
            pg8::EpiSsdIn<false> E{(bf16*)(BIG + BIG_Z), (bf16*)(BIG + BIG_XBC), (float*)(BIG + BIG_DT), SS + (size_t)(2 * layer) * MP,
                            P.in[I_SSD_CW] + (size_t)j * 4 * CONVD, P.in[I_SSD_CB] + (size_t)j * CONVD, P.in[I_SSD_DTB] + (size_t)j * NH, (float*)(BIG + BIG_RAWB),
                            P.out + O_PSSDCONV + (size_t)j * NB * 3 * CONVD, P.out + O_SSSDCONV + (size_t)j * NS * 3 * CONVD, 0, F.lds + EPI_WL_OFF, nullptr, nullptr};
            pg8::EpiSsdIn<true> EK{E.Z, E.XBC, E.DTo, E.ss, E.cw, E.cb, E.dtb, E.rawb, E.outp, E.outs, 0, E.wl,
                            (float*)(P.ws + WS_WT + (size_t)((layer + 1) & 1) * WT_BUF_BYTES), (unsigned*)(P.ws + WS_CTL + CTL_SKF) + (size_t)(5 + j) * SKF_WORDS};
            {
                unsigned long long* ssg = (unsigned long long*)(P.ws + WS_WT + (size_t)((layer + 1) & 1) * WT_BUF_BYTES + SSG_OFF);
                const unsigned zu = __builtin_bit_cast(unsigned, opaque_zero()); const unsigned long long z8 = ((unsigned long long)zu << 32) | zu;
                for (int i = (int)blockIdx.x * (NWAVES * 64) + opaque_i((int)threadIdx.x); i < 8 * MP; i += Gs * (NWAVES * 64)) ssg[i] = z8;
            }
            pg8::gemm_phase<pg8::EpiSsdIn<false>, pg8::RowOrder, true, true>(F.lds + RING_OFF, g, S, E);
            pg8::gemm_phase<pg8::EpiSsdIn<true>, pg8::RowOrderSK, true, true>(F.lds + RING_OFF, g, SK, EK);
            xcd_barrier(bar);
        }
        if (!ssd) { for (int rp = 0; rp < ((PROBE & 1) ? 2 : 1); ++rp) { sc_gate_phase(F, P, j); xcd_barrier(bar); } }
        else { ssd_scan_phase(F, P, j, false, (unsigned long long*)(P.ws + WS_WT + (size_t)((layer + 1) & 1) * WT_BUF_BYTES + SSG_OFF)); xcd_barrier(bar); }
        {
            pg8::Gemm g{ssd ? (const bf16*)(BIG + BIG_Z) : (const bf16*)(BIG + BIG_G), WT + WT_OUT, MP, D, ssd ? DI : D};
            pg8::RowOrder S; S.init(0, MP / 256, D / 256, F.G, opaque_s((int)blockIdx.x)); S.wgm = WGM_RES;
            const int Gs = opaque_s(F.G), rem = S.nwg % Gs; S.lim = S.nwg - rem;
            pg8::RowOrderSK SK{S, S.lim, rem ? min(pg8::SK_MAXPARTS, Gs / rem) : 1, g.K / pg8::BK};
            float* const skp = (float*)(BIG + BIG_SKP); unsigned* const skf = (unsigned*)(P.ws + WS_CTL + CTL_SKF) + (size_t)layer * SKF_WORDS;
            if (!ssd) {
                pg8::EpiRes<false> E{H, SS + (size_t)(2 * layer + 1) * MP, D, 0, nullptr, nullptr, nullptr, 0};
                pg8::EpiRes<true> EK{H, SS + (size_t)(2 * layer + 1) * MP, D, 0, skp, skf, nullptr, 0};
                pg8::gemm_phase<pg8::EpiRes<false>, pg8::RowOrder, true, true>(F.lds + RING_OFF, g, S, E);
                pg8::gemm_phase<pg8::EpiRes<true>, pg8::RowOrderSK, true, true>(F.lds + RING_OFF, g, SK, EK);
            } else {
                const unsigned long long* ssg = (const unsigned long long*)(P.ws + WS_WT + (size_t)((layer + 1) & 1) * WT_BUF_BYTES + SSG_OFF);
                pg8::EpiRes<false, true> E{H, SS + (size_t)(2 * layer + 1) * MP, D, 0, nullptr, nullptr, ssg, MP};
                pg8::EpiRes<true, true> EK{H, SS + (size_t)(2 * layer + 1) * MP, D, 0, skp, skf, ssg, MP};
                pg8::gemm_phase<pg8::EpiRes<false, true>, pg8::RowOrder, true, true>(F.lds + RING_OFF, g, S, E);
                pg8::gemm_phase<pg8::EpiRes<true, true>, pg8::RowOrderSK, true, true>(F.lds + RING_OFF, g, SK, EK);
            }
            xcd_barrier(bar);
        }
        {
            pg8::Gemm g{H, WT + WT_UP, MP, NUP, D};
            pg8::RowOrder S; S.init(0, FFN_ROW_TILES, NUP / 256, F.G, opaque_s((int)blockIdx.x)); S.wgm = WGM_G3; S.rev = 1;
            pg8::EpiFfn E{(bf16*)(BIG + BIG_ACT), P.in[I_FFN_CW] + (size_t)layer * 3 * NUP, P.in[I_FFN_CB] + (size_t)layer * NUP, P.in[I_ST_FFN] + (size_t)layer * NS * 2 * NUP,
                          P.out + O_PFFN + (size_t)layer * NB * 2 * NUP, P.out + O_SFFN + (size_t)layer * NS * 2 * NUP, SS + (size_t)(2 * layer + 1) * MP, 0, F.lds + EPI_WL_OFF};
            constexpr int NR = 1 + ((PROBE & (4 | 64)) ? 1 : 0) + ((PROBE & (16 | 128)) ? 1 : 0);
            for (int rp = 0; rp < NR; ++rp) { E.dry = ((PROBE & (16 | 128)) && rp == 0) ? 1 : 0; pg8::gemm_phase<pg8::EpiFfn, pg8::RowOrder, true, true>(F.lds + RING_OFF, g, S, E); xcd_barrier(bar); }
        }
        {
            pg8::Gemm g{(const bf16*)(BIG + BIG_ACT), WT + WT_DOWN, MP, D, DFF};
            pg8::RowOrder S; S.init(0, MP / 256, D / 256, F.G, opaque_s((int)blockIdx.x)); S.wgm = WGM_RES;
            const int Gs = opaque_s(F.G), rem = S.nwg % Gs;
            if (layer == 3) S.lim = S.nwg - rem;
            pg8::RowOrderSK SK{S, S.lim, rem ? min(pg8::SK_MAXPARTS, Gs / rem) : 1, g.K / pg8::BK};
            pg8::EpiRes<false> E{H, SS + (size_t)(2 * layer + 2) * MP, D, 0, nullptr, nullptr, nullptr, 0};
            pg8::EpiRes<true> EK{H, SS + (size_t)(2 * layer + 2) * MP, D, 0, (float*)(BIG + BIG_SKP), (unsigned*)(P.ws + WS_CTL + CTL_SKF) + (size_t)4 * SKF_WORDS, nullptr, 0};
            pg8::gemm_phase<pg8::EpiRes<false>, pg8::RowOrder, true, true>(F.lds + RING_OFF, g, S, E);
            if (layer < 3) convert_layer_weights(F, P, layer + 1, rem);
            else pg8::gemm_phase<pg8::EpiRes<true>, pg8::RowOrderSK, true, true>(F.lds + RING_OFF, g, SK, EK);
            xcd_barrier(bar);
        }
    }
    for (int rp = 0; rp < ((PROBE & 1) ? 2 : 1); ++rp) final_norm_phase(F, P);
}

extern "C" void kernel_launch(void* const* d_in, const int* in_sizes, int n_in, void* d_out, int out_size, void* d_ws, size_t ws_size, hipStream_t stream) {
    static int grid = 0;
    if (grid == 0) {
        if (n_in != N_IN || in_sizes[I_XP] != NB * SEQ * D || (size_t)out_size != O_END || ws_size < WS_END) {
            fprintf(stderr, "kernel_launch: unexpected shapes (n_in %d, in0 %d, out %d, ws %zu, need %zu); nothing launched\n", n_in, n_in > 0 ? in_sizes[0] : -1, out_size, ws_size, (size_t)WS_END); grid = -1; return; }
        int dev = 0, cus = 0, per_cu = 0;
        if (hipGetDevice(&dev) != hipSuccess || hipDeviceGetAttribute(&cus, hipDeviceAttributeMultiprocessorCount, dev) != hipSuccess) { grid = -1; return; }
        if (hipFuncSetAttribute((const void*)hybrid_fwd, hipFuncAttributeMaxDynamicSharedMemorySize, LDS_BYTES) != hipSuccess) { fprintf(stderr, "kernel_launch: hipFuncSetAttribute failed\n"); grid = -1; return; }
        if (hipOccupancyMaxActiveBlocksPerMultiprocessor(&per_cu, (const void*)hybrid_fwd, NWAVES * 64, LDS_BYTES) != hipSuccess || per_cu < 1) {
            fprintf(stderr, "kernel_launch: occupancy query reports %d workgroups per CU; nothing launched\n", per_cu); (void)hipGetLastError(); grid = -1; return; }
        grid = cus;
    }
    if (grid < 0) return;
    if (hipMemsetAsync((char*)d_ws + WS_CTL, 0, CTL_ZERO_BYTES, stream) != hipSuccess) return;
    Params p{};
    for (int i = 0; i < N_IN; ++i) p.in[i] = (const float*)d_in[i];
    p.out = (float*)d_out; p.ws = (unsigned char*)d_ws;
    hipLaunchKernelGGL(hybrid_fwd, dim3(grid), dim3(NWAVES * 64), LDS_BYTES, stream, p);
}
```
